# Optimizing an MI355X kernel written in HIP

```python
import math
import jax, jax.numpy as jnp
from jax import lax
import numpy as np

D_MODEL = 1024
BATCH = 4
SEQ = 8192
DEPTH = 2

N_MIXERS = 2
ATT_HEADS = 16
ATT_HEAD_DIM = D_MODEL // ATT_HEADS
MOBA_BLOCK = 256
MOBA_TOPK = 3
MOBA_Q_CHUNK = 64
RET_HEADS = 4
RET_KEY_DIM = D_MODEL // RET_HEADS
RET_VAL_DIM = 2 * RET_KEY_DIM
RET_CHUNK = 128
FFN_DIM = 2816
CONV_WIDTH = 3
LN_EPS = 1e-5
GN_EPS = 1e-5
DEEPNORM_ALPHA = (2.0 * DEPTH) ** 0.25
DEEPNORM_BETA = (8.0 * DEPTH) ** -0.25
N_ATT_LAYERS = (DEPTH + 1) // 2
N_RET_LAYERS = DEPTH // 2
NEG_INF = -1e30

kernel_name = "moba_retnet_interleaved_deepnorm_convffn"


def layer_norm(x, g, b):
    xf = x.astype(jnp.float32)
    mu = jnp.mean(xf, axis=-1, keepdims=True)
    var = jnp.mean(jnp.square(xf - mu), axis=-1, keepdims=True)
    y = (xf - mu) * lax.rsqrt(var + LN_EPS)
    return (y * g + b).astype(x.dtype)


def moba_attention(x, w_in, w_out):
    B, S, _ = x.shape
    H, hd = ATT_HEADS, ATT_HEAD_DIM
    QC, BLK = MOBA_Q_CHUNK, MOBA_BLOCK
    q, k, v = jnp.split(x @ w_in, 3, axis=-1)

    def heads(t):
        return t.reshape(B, S, H, hd).transpose(0, 2, 1, 3)

    q = heads(q) * (hd ** -0.5)
    k, v = heads(k), heads(v)
    n_blk = -(-S // BLK)
    s_pad = n_blk * BLK
    pad = ((0, 0), (0, 0), (0, s_pad - S), (0, 0))
    k_blk = jnp.pad(k, pad).reshape(B, H, n_blk, BLK, hd)
    v_blk = jnp.pad(v, pad).reshape(B, H, n_blk, BLK, hd)
    k_mean = jnp.mean(k_blk.astype(jnp.float32), axis=3).astype(k.dtype)
    n_q = S // QC
    q_chunks = q.reshape(B, H, n_q, QC, hd)
    top_k = min(MOBA_TOPK, n_blk)
    slopes = jnp.exp2(-8.0 * jnp.arange(1, H + 1, dtype=jnp.float32) / H)
    h_idx = jnp.arange(H)[:, None, None]
    blk_ids = jnp.arange(n_blk)
    offs = jnp.arange(BLK)

    def one_chunk(n):
        b = n // n_q
        c = n % n_q
        qc = q_chunks[b, :, c]
        t = c * QC + jnp.arange(QC)
        j = (c * QC) // BLK
        kb, vb, km = k_blk[b], v_blk[b], k_mean[b]
        gate = jnp.einsum('hqd,hnd->hqn', qc, km).astype(jnp.float32)
        gate = jnp.where(blk_ids < j, gate, NEG_INF)
        _, sel = lax.top_k(gate, top_k)
        sel_ok = jnp.arange(top_k) < j
        sel = jnp.where(sel_ok, sel, 0)
        k_sel = kb[h_idx, sel]
        v_sel = vb[h_idx, sel]
        s_sel = jnp.einsum('hqd,hqrkd->hqrk', qc, k_sel).astype(jnp.float32)
        pos_sel = sel[..., None] * BLK + offs
        dist_sel = (t[None, :, None, None] - pos_sel).astype(jnp.float32)
        s_sel = s_sel - slopes[:, None, None, None] * dist_sel
        s_sel = jnp.where(sel_ok[None, None, :, None], s_sel, NEG_INF)
        s_sel = s_sel.reshape(H, QC, top_k * BLK)
        k_own = lax.dynamic_index_in_dim(kb, j, axis=1, keepdims=False)
        v_own = lax.dynamic_index_in_dim(vb, j, axis=1, keepdims=False)
        dist_own = (t[:, None] - (j * BLK + offs)[None, :]).astype(jnp.float32)
        s_own = jnp.einsum('hqd,hkd->hqk', qc, k_own).astype(jnp.float32)
        s_own = s_own - slopes[:, None, None] * dist_own
        s_own = jnp.where(dist_own >= 0, s_own, NEG_INF)
        p = jax.nn.softmax(jnp.concatenate([s_sel, s_own], axis=-1), axis=-1).astype(v.dtype)
        p_sel = p[..., :top_k * BLK].reshape(H, QC, top_k, BLK)
        p_own = p[..., top_k * BLK:]
        return (jnp.einsum('hqrk,hqrkd->hqd', p_sel, v_sel)
                + jnp.einsum('hqk,hkd->hqd', p_own, v_own))

    out = lax.map(one_chunk, jnp.arange(B * n_q))
    out = out.reshape(B, n_q, H, QC, hd).transpose(0, 1, 3, 2, 4).reshape(B, S, H * hd)
    return out @ w_out


def retention(x, w_in, w_out, gn_g, gn_b):
    B, S, _ = x.shape
    H, dk, dv, C = RET_HEADS, RET_KEY_DIM, RET_VAL_DIM, RET_CHUNK
    q, k, v, g = jnp.split(x @ w_in, [H * dk, 2 * H * dk, 2 * H * dk + H * dv], axis=-1)
    n_c = S // C

    def chunks(t, d):
        return t.reshape(B, n_c, C, H, d).transpose(1, 0, 3, 2, 4).astype(jnp.float32)

    qc = chunks(q, dk)
    kc = chunks(k, dk) * (dk ** -0.5)
    vc = chunks(v, dv)
    log_gamma = jnp.log1p(-jnp.exp2(-5.0 - jnp.arange(H, dtype=jnp.float32)))
    i = jnp.arange(C, dtype=jnp.float32)
    diff = i[:, None] - i[None, :]
    decay_in = jnp.where(diff >= 0, jnp.exp(log_gamma[:, None, None] * jnp.maximum(diff, 0.0)), 0.0)
    q_decay = jnp.exp(log_gamma[:, None] * (i + 1.0))
    k_decay = jnp.exp(log_gamma[:, None] * (C - 1.0 - i))
    chunk_decay = jnp.exp(log_gamma * C)

    def step(state, inp):
        qi, ki, vi = inp
        scores = jnp.einsum('bhqd,bhkd->bhqk', qi, ki) * decay_in
        inner = jnp.einsum('bhqk,bhkv->bhqv', scores, vi)
        cross = jnp.einsum('bhqd,bhdv->bhqv', qi * q_decay[..., None], state)
        state = (chunk_decay[:, None, None] * state
                 + jnp.einsum('bhkd,bhkv->bhdv', ki * k_decay[..., None], vi))
        return state, inner + cross

    state0 = jnp.zeros((B, H, dk, dv), jnp.float32)
    _, o = lax.scan(step, state0, (qc, kc, vc))
    o = o.transpose(1, 0, 3, 2, 4).reshape(B, S, H, dv)
    mu = jnp.mean(o, axis=-1, keepdims=True)
    var = jnp.mean(jnp.square(o - mu), axis=-1, keepdims=True)
    o = ((o - mu) * lax.rsqrt(var + GN_EPS)).reshape(B, S, H * dv)
    o = (o * gn_g + gn_b).astype(x.dtype) * jax.nn.silu(g)
    return o @ w_out


def conv_ffn(x, w_up, conv_w, conv_b, w_down):
    S = x.shape[1]
    u = x @ w_up
    u_pad = jnp.pad(u, ((0, 0), (CONV_WIDTH - 1, 0), (0, 0)))
    h = conv_b + conv_w[CONV_WIDTH - 1] * u_pad[:, CONV_WIDTH - 1:CONV_WIDTH - 1 + S]
    for w in range(CONV_WIDTH - 1):
        h = h + conv_w[w] * u_pad[:, w:w + S]
    a, gate = jnp.split(h, 2, axis=-1)
    return (jax.nn.gelu(a, approximate=False) * gate) @ w_down


def setup_inputs(seed: int = 0) -> dict:
    key = jax.random.key(seed)
    ks = jax.random.split(key, 16)
    f32 = jnp.float32
    D, F = D_MODEL, FFN_DIM
    ret_in = 2 * RET_HEADS * RET_KEY_DIM + 2 * RET_HEADS * RET_VAL_DIM
    ret_v = RET_HEADS * RET_VAL_DIM

    def nrm(k, shape, fan_in, scale=1.0):
        return jax.random.normal(k, shape, f32) * (fan_in ** -0.5) * scale

    return {
        "x": jax.random.normal(ks[0], (BATCH, SEQ, D), f32),
        "att_w_in": nrm(ks[1], (N_ATT_LAYERS, D, 3 * D), D),
        "att_w_out": nrm(ks[2], (N_ATT_LAYERS, D, D), D, DEEPNORM_BETA),
        "ret_w_in": nrm(ks[3], (N_RET_LAYERS, D, ret_in), D),
        "ret_w_out": nrm(ks[4], (N_RET_LAYERS, ret_v, D), ret_v, DEEPNORM_BETA),
        "ret_gn_g": 1.0 + 0.02 * jax.random.normal(ks[5], (N_RET_LAYERS, ret_v), f32),
        "ret_gn_b": 0.02 * jax.random.normal(ks[6], (N_RET_LAYERS, ret_v), f32),
        "mix_ln_g": 1.0 + 0.02 * jax.random.normal(ks[7], (DEPTH, D), f32),
        "mix_ln_b": 0.02 * jax.random.normal(ks[8], (DEPTH, D), f32),
        "ffn_ln_g": 1.0 + 0.02 * jax.random.normal(ks[9], (DEPTH, D), f32),
        "ffn_ln_b": 0.02 * jax.random.normal(ks[10], (DEPTH, D), f32),
        "ffn_w_up": nrm(ks[11], (DEPTH, D, 2 * F), D),
        "ffn_conv_w": nrm(ks[12], (DEPTH, CONV_WIDTH, 2 * F), CONV_WIDTH),
        "ffn_conv_b": 0.02 * jax.random.normal(ks[13], (DEPTH, 2 * F), f32),
        "ffn_w_down": nrm(ks[14], (DEPTH, F, D), F, DEEPNORM_BETA),
    }


def reference(x, att_w_in, att_w_out, ret_w_in, ret_w_out, ret_gn_g, ret_gn_b,
              mix_ln_g, mix_ln_b, ffn_ln_g, ffn_ln_b, ffn_w_up, ffn_conv_w,
              ffn_conv_b, ffn_w_down):
    for i in range(DEPTH):
        slot = i // N_MIXERS
        if i % N_MIXERS == 0:
            y = moba_attention(x, att_w_in[slot], att_w_out[slot])
        else:
            y = retention(x, ret_w_in[slot], ret_w_out[slot], ret_gn_g[slot], ret_gn_b[slot])
        x = layer_norm(DEEPNORM_ALPHA * x + y, mix_ln_g[i], mix_ln_b[i])
        f = conv_ffn(x, ffn_w_up[i], ffn_conv_w[i], ffn_conv_b[i], ffn_w_down[i])
        x = layer_norm(DEEPNORM_ALPHA * x + f, ffn_ln_g[i], ffn_ln_b[i])
    return x
```

```cpp
#include <hip/hip_runtime.h>
#include <math.h>
#include <stdint.h>

namespace sl {
constexpr int D = 1024, NBATCH = 4, S = 8192, H = 16, HD = 64, BLK = 256, NBLK = S / BLK;
constexpr int RH = 4, DK = 256, DV = 512, RC = 128, NCH = S / RC;
constexpr int F = 2816, F2 = 5632, RIN = 6144, RV = 2048;
constexpr float ALPHA = 1.4142135623730951f;
constexpr float LN_EPS = 1e-5f, GN_EPS = 1e-5f;
constexpr size_t MiB = 1u << 20;
constexpr size_t WS_XA = 0, WS_BIG = 128 * MiB, WS_R2 = 320 * MiB, WS_R3 = 448 * MiB;

template <class LA, class LB, class ST>
__global__ __launch_bounds__(256) void fgemm(LA la, LB lb, ST st, int K) {
    __shared__ float As[16][132];
    __shared__ float Bs[16][132];
    const int tid = threadIdx.x, tx = tid & 15, ty = tid >> 4;
    const int m0 = blockIdx.y * 128, n0 = blockIdx.x * 128, z = blockIdx.z;
    float acc[8][8];
#pragma unroll
    for (int i = 0; i < 8; ++i)
#pragma unroll
        for (int j = 0; j < 8; ++j) acc[i][j] = 0.f;
    for (int k0 = 0; k0 < K; k0 += 16) {
#pragma unroll
        for (int i = 0; i < 8; ++i) { const int m = (tid >> 4) + 16 * i; As[tid & 15][m] = la(z, m0 + m, k0 + (tid & 15)); }
#pragma unroll
        for (int i = 0; i < 8; ++i) { const int k = (tid >> 7) + 2 * i; Bs[k][tid & 127] = lb(z, k0 + k, n0 + (tid & 127)); }
        __syncthreads();
#pragma unroll
        for (int kk = 0; kk < 16; ++kk) {
            float a[8], b[8];
#pragma unroll
            for (int i = 0; i < 4; ++i) { a[i] = As[kk][ty * 4 + i]; a[4 + i] = As[kk][64 + ty * 4 + i]; b[i] = Bs[kk][tx * 4 + i]; b[4 + i] = Bs[kk][64 + tx * 4 + i]; }
#pragma unroll
            for (int i = 0; i < 8; ++i)
#pragma unroll
                for (int j = 0; j < 8; ++j) acc[i][j] = fmaf(a[i], b[j], acc[i][j]);
        }
        __syncthreads();
    }
#pragma unroll
    for (int i = 0; i < 8; ++i)
#pragma unroll
        for (int j = 0; j < 8; ++j) {
            const int m = m0 + (i < 4 ? ty * 4 + i : 64 + ty * 4 + (i - 4)), n = n0 + (j < 4 ? tx * 4 + j : 64 + tx * 4 + (j - 4));
            st(z, m, n, acc[i][j]);
        }
}
struct LdRM { const float* p; long ld; __device__ float operator()(int, int r, int c) const { return p[(long)r * ld + c]; } };
struct StRM { float* p; long ld; __device__ void operator()(int, int m, int n, float v) const { p[(long)m * ld + n] = v; } };

__device__ __forceinline__ float ret_lg(int h) { return log1pf(-exp2f(-5.0f - (float)h)); }
struct LdQ  { const float* P; __device__ float operator()(int z, int m, int k) const { const int h = z >> 6, i = z & 63; return P[(long)(i * 128 + m) * 6144 + h * 256 + k]; } };
struct LdQd { const float* P; __device__ float operator()(int z, int m, int k) const { const int h = z >> 6, i = z & 63; return P[(long)(i * 128 + m) * 6144 + h * 256 + k] * expf(ret_lg(h) * (float)(m + 1)); } };
struct LdKt { const float* P; __device__ float operator()(int z, int k, int n) const { const int h = z >> 6, i = z & 63; return P[(long)(i * 128 + n) * 6144 + 1024 + h * 256 + k] * 0.0625f; } };
struct LdKd { const float* P; __device__ float operator()(int z, int m, int k) const { const int h = z >> 6, i = z & 63; return P[(long)(i * 128 + k) * 6144 + 1024 + h * 256 + m] * 0.0625f * expf(ret_lg(h) * (float)(127 - k)); } };
struct LdV  { const float* P; __device__ float operator()(int z, int k, int n) const { const int h = z >> 6, i = z & 63; return P[(long)(i * 128 + k) * 6144 + 2048 + h * 512 + n]; } };
struct LdZ  { const float* p; long zs; long ld; __device__ float operator()(int z, int r, int c) const { return p[(long)z * zs + (long)r * ld + c]; } };
struct StSc { float* sc; __device__ void operator()(int z, int m, int n, float v) const { const int h = z >> 6; sc[(long)z * 16384 + m * 128 + n] = (m >= n) ? v * expf(ret_lg(h) * (float)(m - n)) : 0.f; } };
struct StZ  { float* p; long zs; long ld; __device__ void operator()(int z, int m, int n, float v) const { p[(long)z * zs + (long)m * ld + n] = v; } };
struct StO  { float* o; int acc; int pad; __device__ void operator()(int z, int m, int n, float v) const { const int h = z >> 6, i = z & 63; float* d = o + (long)(i * 128 + m) * 2048 + h * 512 + n; *d = acc ? *d + v : v; } };

__global__ void ret_scan(float* KV) {
    const int e = blockIdx.x * 256 + threadIdx.x, h = blockIdx.y;
    const float cd = expf(ret_lg(h) * 128.f);
    float s = 0.f;
    for (int i = 0; i < 64; ++i) { float* p = KV + ((long)(h * 64 + i) * 131072 + e); const float cur = *p; *p = s; s = cd * s + cur; }
}
__global__ __launch_bounds__(64) void ret_gn_gate(float* o, const float* P, const float* gg, const float* gb) {
    const int t = blockIdx.x, h = blockIdx.y, lane = threadIdx.x;
    float* r = o + (long)t * 2048 + h * 512; float v[8]; float s = 0.f;
#pragma unroll
    for (int i = 0; i < 8; ++i) { v[i] = r[lane + 64 * i]; s += v[i]; }
#pragma unroll
    for (int off = 1; off < 64; off <<= 1) s += __shfl_xor(s, off);
    const float mu = s * (1.f / 512.f); float q = 0.f;
#pragma unroll
    for (int i = 0; i < 8; ++i) { v[i] -= mu; q += v[i] * v[i]; }
#pragma unroll
    for (int off = 1; off < 64; off <<= 1) q += __shfl_xor(q, off);
    const float rstd = rsqrtf(q * (1.f / 512.f) + GN_EPS);
#pragma unroll
    for (int i = 0; i < 8; ++i) { const int c = h * 512 + lane + 64 * i; const float g = P[(long)t * 6144 + 4096 + c]; const float sg = g / (1.f + expf(-g)); r[lane + 64 * i] = (v[i] * rstd * gg[c] + gb[c]) * sg; }
}
__global__ __launch_bounds__(64) void ln_kernel(const float* xin, const float* y, const float* g, const float* b, float* out) {
    const long row = blockIdx.x; const int lane = threadIdx.x;
    float v[16]; float s = 0.f;
#pragma unroll
    for (int i = 0; i < 16; ++i) { const int c = lane + 64 * i; v[i] = ALPHA * xin[row * D + c] + y[row * D + c]; s += v[i]; }
#pragma unroll
    for (int off = 1; off < 64; off <<= 1) s += __shfl_xor(s, off);
    const float mu = s * (1.f / D); float q = 0.f;
#pragma unroll
    for (int i = 0; i < 16; ++i) { v[i] -= mu; q += v[i] * v[i]; }
#pragma unroll
    for (int off = 1; off < 64; off <<= 1) q += __shfl_xor(q, off);
    const float rstd = rsqrtf(q * (1.f / D) + LN_EPS);
#pragma unroll
    for (int i = 0; i < 16; ++i) { const int c = lane + 64 * i; out[row * D + c] = v[i] * rstd * g[c] + b[c]; }
}
__global__ void conv_gate(const float* u, const float* cw, const float* cb, float* g) {
    const int c = blockIdx.x * 256 + threadIdx.x, t = blockIdx.y;
    if (c >= F) return;
    float a = cb[c] + cw[2 * F2 + c] * u[(long)t * F2 + c], gt = cb[F + c] + cw[2 * F2 + F + c] * u[(long)t * F2 + F + c];
    if (t >= 1) { a += cw[1 * F2 + c] * u[(long)(t - 1) * F2 + c]; gt += cw[1 * F2 + F + c] * u[(long)(t - 1) * F2 + F + c]; }
    if (t >= 2) { a += cw[0 * F2 + c] * u[(long)(t - 2) * F2 + c]; gt += cw[0 * F2 + F + c] * u[(long)(t - 2) * F2 + F + c]; }
    const float ge = 0.5f * a * (1.f + erff(a * 0.70710678118654752f));
    g[(long)t * F + c] = ge * gt;
}
__global__ __launch_bounds__(64) void kmean_kernel(const float* qkv, float* kmean) {
    const int n = blockIdx.x, h = blockIdx.y, d = threadIdx.x; float s = 0.f;
    for (int r = 0; r < 256; ++r) s += qkv[(long)(n * 256 + r) * 3072 + 1024 + h * 64 + d];
    kmean[(h * 32 + n) * 64 + d] = s * (1.f / 256.f);
}
__global__ __launch_bounds__(64) void topk_kernel(const float* qkv, const float* kmean, int* sel) {
    const int t = blockIdx.x * 64 + threadIdx.x, h = blockIdx.y, j = t >> 8;
    float q[64];
#pragma unroll
    for (int d = 0; d < 64; ++d) q[d] = qkv[(long)t * 3072 + h * 64 + d] * 0.125f;
    float v0 = -INFINITY, v1 = -INFINITY, v2 = -INFINITY; int i0 = 0, i1 = 0, i2 = 0;
    for (int n = 0; n < j; ++n) {
        const float* km = kmean + (h * 32 + n) * 64; float g = 0.f;
#pragma unroll
        for (int d = 0; d < 64; ++d) g = fmaf(q[d], km[d], g);
        if (g > v0) { v2 = v1; i2 = i1; v1 = v0; i1 = i0; v0 = g; i0 = n; }
        else if (g > v1) { v2 = v1; i2 = i1; v1 = g; i1 = n; }
        else if (g > v2) { v2 = g; i2 = n; }
    }
    int* o = sel + ((long)t * 16 + h) * 3; o[0] = i0; o[1] = i1; o[2] = i2;
}
__global__ __launch_bounds__(64) void attn_slow(const float* qkv, const int* sel, float* out) {
    const int t = blockIdx.x * 64 + threadIdx.x, h = blockIdx.y, j = t >> 8;
    float q[64], o[64];
#pragma unroll
    for (int d = 0; d < 64; ++d) { q[d] = qkv[(long)t * 3072 + h * 64 + d] * 0.125f; o[d] = 0.f; }
    const float slope = exp2f(-0.5f * (float)(h + 1));
    float m = -INFINITY, l = 0.f;
    const int nsel = j < 3 ? j : 3;
    for (int r = 0; r <= nsel; ++r) {
        const int blk = (r < nsel) ? sel[((long)t * 16 + h) * 3 + r] : j;
        const int kend = (r < nsel) ? 256 : (t & 255) + 1;
        for (int kk = 0; kk < kend; ++kk) {
            const int pos = blk * 256 + kk;
            const float4* kr = (const float4*)(qkv + (long)pos * 3072 + 1024 + h * 64);
            float s = 0.f;
#pragma unroll
            for (int d4 = 0; d4 < 16; ++d4) { const float4 kv = kr[d4]; s = fmaf(q[4 * d4], kv.x, s); s = fmaf(q[4 * d4 + 1], kv.y, s); s = fmaf(q[4 * d4 + 2], kv.z, s); s = fmaf(q[4 * d4 + 3], kv.w, s); }
            s -= slope * (float)(t - pos);
            const float mn = fmaxf(m, s), corr = expf(m - mn), p = expf(s - mn);
            l = l * corr + p; m = mn;
            const float4* vr = (const float4*)(qkv + (long)pos * 3072 + 2048 + h * 64);
#pragma unroll
            for (int d4 = 0; d4 < 16; ++d4) { const float4 vv = vr[d4];
                o[4 * d4] = fmaf(p, vv.x, o[4 * d4] * corr); o[4 * d4 + 1] = fmaf(p, vv.y, o[4 * d4 + 1] * corr);
                o[4 * d4 + 2] = fmaf(p, vv.z, o[4 * d4 + 2] * corr); o[4 * d4 + 3] = fmaf(p, vv.w, o[4 * d4 + 3] * corr); }
        }
    }
    const float il = 1.f / l;
#pragma unroll
    for (int d = 0; d < 64; ++d) out[(long)t * 1024 + h * 64 + d] = o[d] * il;
}

template <class LA, class LB, class ST> static void launch_fgemm(LA la, LB lb, ST st, int M, int N, int K, int Z, hipStream_t s) {
    hipLaunchKernelGGL((fgemm<LA, LB, ST>), dim3(N / 128, M / 128, Z), dim3(256), 0, s, la, lb, st, K);
}
static void gemm_rm(const float* A, long lda, const float* Bm, long ldb, float* C, long ldc, int M, int N, int K, hipStream_t s) {
    LdRM la{}; la.p = A; la.ld = lda; LdRM lb{}; lb.p = Bm; lb.ld = ldb; StRM st{}; st.p = C; st.ld = ldc; launch_fgemm(la, lb, st, M, N, K, 1, s);
}

static void slow_forward(void* const* d_in, float* out, char* ws, hipStream_t s) {
    const float* x = (const float*)d_in[0];
    const float* att_w_in = (const float*)d_in[1]; const float* att_w_out = (const float*)d_in[2];
    const float* ret_w_in = (const float*)d_in[3]; const float* ret_w_out = (const float*)d_in[4];
    const float* ret_gn_g = (const float*)d_in[5]; const float* ret_gn_b = (const float*)d_in[6];
    const float* mix_ln_g = (const float*)d_in[7]; const float* mix_ln_b = (const float*)d_in[8];
    const float* ffn_ln_g = (const float*)d_in[9]; const float* ffn_ln_b = (const float*)d_in[10];
    const float* ffn_w_up = (const float*)d_in[11]; const float* ffn_conv_w = (const float*)d_in[12];
    const float* ffn_conv_b = (const float*)d_in[13]; const float* ffn_w_down = (const float*)d_in[14];
    float* XA = (float*)(ws + WS_XA); float* BIG = (float*)(ws + WS_BIG); float* R2 = (float*)(ws + WS_R2); float* R3 = (float*)(ws + WS_R3);
    for (int layer = 0; layer < 2; ++layer) {
        const float* xin = layer == 0 ? x : out;
        for (int b = 0; b < NBATCH; ++b) {
            const float* xb = xin + (size_t)b * S * D; float* xab = XA + (size_t)b * S * D; float* y = nullptr;
            if (layer == 0) {
                gemm_rm(xb, D, att_w_in, 3 * D, BIG, 3 * D, S, 3 * D, D, s);
                float* kmean = R3; int* sel = (int*)(R3 + 65536); float* ao = R2; y = R2 + (size_t)S * D;
                hipLaunchKernelGGL(kmean_kernel, dim3(32, 16), dim3(64), 0, s, BIG, kmean);
                hipLaunchKernelGGL(topk_kernel, dim3(S / 64, 16), dim3(64), 0, s, BIG, kmean, sel);
                hipLaunchKernelGGL(attn_slow, dim3(S / 64, 16), dim3(64), 0, s, BIG, sel, ao);
                gemm_rm(ao, D, att_w_out, D, y, D, S, D, D, s);
            } else {
                gemm_rm(xb, D, ret_w_in, RIN, BIG, RIN, S, RIN, D, s);
                float* sc = XA + (size_t)b * S * D;
                float* KV = R2; float* o = R3;
                { LdQ la{}; la.P = BIG; LdKt lb{}; lb.P = BIG; StSc st{}; st.sc = sc; launch_fgemm(la, lb, st, 128, 128, 256, 256, s); }
                { LdKd la{}; la.P = BIG; LdV lb{}; lb.P = BIG; StZ st{}; st.p = KV; st.zs = 131072; st.ld = 512; launch_fgemm(la, lb, st, 256, 512, 128, 256, s); }
                hipLaunchKernelGGL(ret_scan, dim3(512, 4), dim3(256), 0, s, KV);
                { LdZ la{}; la.p = sc; la.zs = 16384; la.ld = 128; LdV lb{}; lb.P = BIG; StO st{}; st.o = o; st.acc = 0; launch_fgemm(la, lb, st, 128, 512, 128, 256, s); }
                { LdQd la{}; la.P = BIG; LdZ lb{}; lb.p = KV; lb.zs = 131072; lb.ld = 512; StO st{}; st.o = o; st.acc = 1; launch_fgemm(la, lb, st, 128, 512, 256, 256, s); }
                hipLaunchKernelGGL(ret_gn_gate, dim3(S, 4), dim3(64), 0, s, o, BIG, ret_gn_g, ret_gn_b);
                y = R2;
                gemm_rm(o, RV, ret_w_out, D, y, D, S, D, RV, s);
            }
            hipLaunchKernelGGL(ln_kernel, dim3(S), dim3(64), 0, s, xb, y, mix_ln_g + layer * D, mix_ln_b + layer * D, xab);
            gemm_rm(xab, D, ffn_w_up + (size_t)layer * D * F2, F2, BIG, F2, S, F2, D, s);
            hipLaunchKernelGGL(conv_gate, dim3(F / 256, S), dim3(256), 0, s, BIG, ffn_conv_w + (size_t)layer * 3 * F2, ffn_conv_b + (size_t)layer * F2, R2);
            gemm_rm(R2, F, ffn_w_down + (size_t)layer * F * D, D, R3, D, S, D, F, s);
            hipLaunchKernelGGL(ln_kernel, dim3(S), dim3(64), 0, s, xab, R3, ffn_ln_g + layer * D, ffn_ln_b + layer * D, out + (size_t)b * S * D);
        }
    }
}
}

extern "C" void kernel_launch(void* const* d_in, const int* in_sizes, int n_in, void* d_out, int out_size, void* d_ws, size_t ws_size, hipStream_t stream) {
    (void)in_sizes; (void)n_in; (void)out_size; (void)ws_size;
    sl::slow_forward(d_in, (float*)d_out, (char*)d_ws, stream);
}
```

```cpp
#include <hip/hip_runtime.h>
#include <hip/hip_bf16.h>
#include <math.h>
#include <stdint.h>
namespace pg8 {
#define PG8_LAS __attribute__((address_space(3)))
typedef unsigned short bf16_t;
typedef short bf16x8 __attribute__((ext_vector_type(8)));
typedef float f32x4 __attribute__((ext_vector_type(4)));
typedef unsigned u32x4 __attribute__((ext_vector_type(4)));
constexpr int BM = 256, BK = 64, HALF = 128, HTB = HALF * BK * 2  , STAGE_BYTES = 8 * HTB, NXCD = 8, WGM = 8;

__host__ __device__ __forceinline__ int lds_byte(int r, int c) { const int st = (r >> 4) * 2 + (c >> 5), rr = r & 15, cc = c & 31, ob = rr * 64 + cc * 2; return st * 1024 + (ob ^ (((ob >> 9) & 1) << 5)); }
__host__ __device__ __forceinline__ void stage_rc(int b, int& R, int& C) { const int st = b / 1024, sb = b % 1024, swz = sb ^ (((sb >> 9) & 1) << 5); R = (st >> 1) * 16 + swz / 64; C = (st & 1) * 32 + (swz % 64) / 2; }
__host__ __device__ __forceinline__ int perm32(int rho) { const int n = rho >> 4, i = rho & 15; return 8 * (i >> 2) + 4 * n + (i & 3); }

struct Unit { int pm, pn; };
struct Gemm { const bf16_t* A; const bf16_t* Bt; int M, N, K; };

struct StaticOrder {
    int nM, nN, nwg, G, c;
    __host__ __device__ void init(int M, int N, int G_, int c_) { nM = M / BM; nN = N / BM; nwg = nM * nN; G = G_; c = c_; }
    __host__ __device__ bool next(int i, Unit& u) const {
        const long L = (long)i * G + c; if (L >= nwg) return false;
        int wgid = (int)L; { const int q = nwg / NXCD, r = nwg % NXCD, xcd = wgid % NXCD, off = wgid / NXCD; wgid = (xcd < r ? xcd * (q + 1) : r * (q + 1) + (xcd - r) * q) + off; }
        const int nig = WGM * nN, gid = wgid / nig, fm = gid * WGM, gsz = (nM - fm) < WGM ? (nM - fm) : WGM;
        u.pm = fm + ((wgid % nig) % gsz); u.pn = (wgid % nig) / gsz; return true;
    }
    __device__ __forceinline__ void a_ready(const Unit&) const {}
    __device__ __forceinline__ void done(const Unit&) const {}
};

__device__ __forceinline__ unsigned cvt_pk_bf16(float lo, float hi) { unsigned r; asm volatile("v_cvt_pk_bf16_f32 %0, %1, %2" : "=v"(r) : "v"(lo), "v"(hi)); return r; }
typedef float f32x2 __attribute__((ext_vector_type(2)));
__device__ __forceinline__ f32x2 gelu_pk(f32x2 v) {
    const f32x2 av = __builtin_elementwise_abs(v), d = av * 0.2316418882f + 1.0f;
    f32x2 t; t.x = __builtin_amdgcn_rcpf(d.x); t.y = __builtin_amdgcn_rcpf(d.y);
    f32x2 q = t * 0.5307027145f + (-0.7265760135f); q = q * t + 0.7107068705f; q = q * t + (-0.142248368f); q = q * t + 0.127414796f; q = q * t;
    const f32x2 s = (v * v) * (-0.72134752044f);
    f32x2 e; e.x = __builtin_amdgcn_exp2f(s.x); e.y = __builtin_amdgcn_exp2f(s.y);
    const f32x2 m = v * (q * e), r = v - m;
    f32x2 o; o.x = v.x < 0.f ? m.x : r.x; o.y = v.y < 0.f ? m.y : r.y; return o;
}
template <int ACT  > struct EpiBf16 {
    static constexpr bool PERM = true, AFTER_DRAIN = false; static_assert(ACT == 0 || ACT == 1, "EpiBf16: ACT is 0 (none) or 1 (gelu_pk)");
    bf16_t* O; int ldc; const float* bias; int split_cols; size_t split_stride; float scale0;
    __device__ __forceinline__ void operator()(const f32x4 (&acc)[2][2][4][2], const Unit& u, int wr, int wc, int fr, int fq) const {
        const int row0 = u.pm * BM + wr * 64 + fr; int colt = u.pn * BM; bf16_t* base = O;
        float sc = 1.f; if (split_cols) { const int t = colt / split_cols; base += (size_t)t * split_stride; colt -= t * split_cols; if (t == 0) sc = scale0; }
        const int col0 = colt + wc * 32 + 8 * fq, bcol0 = u.pn * BM + wc * 32 + 8 * fq;
        f32x4 bv[2][2];
#pragma unroll
        for (int bj = 0; bj < 2; ++bj)
#pragma unroll
            for (int n = 0; n < 2; ++n) bv[bj][n] = bias ? *(const f32x4*)(bias + bcol0 + bj * HALF + 4 * n) : (f32x4){0.f, 0.f, 0.f, 0.f};
#pragma unroll
        for (int ai = 0; ai < 2; ++ai)
#pragma unroll
            for (int m = 0; m < 4; ++m) { bf16_t* rowp = base + (size_t)(row0 + ai * HALF + m * 16) * ldc + col0;
#pragma unroll
                for (int bj = 0; bj < 2; ++bj) { f32x4 v0 = acc[ai][bj][m][0] + bv[bj][0], v1 = acc[ai][bj][m][1] + bv[bj][1];
                    if (ACT == 1) { f32x2 a = gelu_pk((f32x2){v0[0], v0[1]}), b = gelu_pk((f32x2){v0[2], v0[3]}), c = gelu_pk((f32x2){v1[0], v1[1]}), d = gelu_pk((f32x2){v1[2], v1[3]});
                        v0 = (f32x4){a.x, a.y, b.x, b.y}; v1 = (f32x4){c.x, c.y, d.x, d.y}; }
                    v0 = v0 * sc; v1 = v1 * sc; u32x4 w; w.x = cvt_pk_bf16(v0[0], v0[1]); w.y = cvt_pk_bf16(v0[2], v0[3]); w.z = cvt_pk_bf16(v1[0], v1[1]); w.w = cvt_pk_bf16(v1[2], v1[3]);
                    *(u32x4*)(rowp + bj * HALF) = w; } }
    }
};
template <class Epi, class Sched, bool ALIGN_EPI = false, bool SP2 = false>
__device__ __forceinline__ void gemm_phase(PG8_LAS unsigned char* lds, const Gemm g, const Sched& S, const Epi& E) {
    const int tid = threadIdx.x, wid = __builtin_amdgcn_readfirstlane(tid >> 6), lane = tid & 63, wr = wid >> 2, wc = wid & 3, fr = lane & 15, fq = lane >> 4;
    const int K = g.K, nt = K / BK;
    unsigned voffA[2], voffB[2];
#pragma unroll
    for (int i = 0; i < 2; ++i) { int R, C; stage_rc(tid * 16 + i * 8192, R, C); const int Rb = Epi::PERM ? ((R & ~31) + perm32(R & 31)) : R;
        voffA[i] = (unsigned)(R * K + C) * 2u; voffB[i] = (unsigned)(Rb * K + C) * 2u; }
    const size_t kstep = (size_t)(BK * 2);
    const size_t hstep = (size_t)HALF * K * 2;
    const size_t tstep = 2 * hstep;
    const unsigned ldsw = (unsigned)wid * 1024u;
    const int aoff = lds_byte(wr * 64 + fr, fq * 8), boff = lds_byte(wc * 32 + fr, fq * 8);
#define PG8_SA(b, h) (((b) * 2 + (h)) * HTB)
#define PG8_SB(b, h) ((4 + (b) * 2 + (h)) * HTB)
#define PG8_STAGE(bufoff, gbase, voff) do { _Pragma("unroll") for (int _i = 0; _i < 2; ++_i) \
        __builtin_amdgcn_global_load_lds((const unsigned*)((const char*)(gbase) + (voff)[_i]), (PG8_LAS unsigned*)(lds + (bufoff) + ldsw + _i * 8192), 16, 0, 0); } while (0)
#define PG8_LDA(dst, b, h) do { _Pragma("unroll") for (int m = 0; m < 4; ++m) _Pragma("unroll") for (int k = 0; k < 2; ++k) dst[m][k] = *(const PG8_LAS bf16x8*)(lds + PG8_SA(b, h) + aoff + m * 2048 + k * 1024); } while (0)
#define PG8_LDB(dst, b, h) do { _Pragma("unroll") for (int n = 0; n < 2; ++n) _Pragma("unroll") for (int k = 0; k < 2; ++k) dst[n][k] = *(const PG8_LAS bf16x8*)(lds + PG8_SB(b, h) + boff + n * 2048 + k * 1024); } while (0)
#define PG8_MMA(ai, bj, At, Bt) do { __builtin_amdgcn_s_setprio(1); _Pragma("unroll") for (int m = 0; m < 4; ++m) _Pragma("unroll") for (int n = 0; n < 2; ++n) _Pragma("unroll") for (int k = 0; k < 2; ++k) \
        acc[ai][bj][m][n] = __builtin_amdgcn_mfma_f32_16x16x32_bf16(Bt[n][k], At[m][k], acc[ai][bj][m][n], 0, 0, 0); __builtin_amdgcn_s_setprio(0); } while (0)
#define PG8_WAIT_V(n) asm volatile("s_waitcnt vmcnt(" #n ")" ::: "memory")
#define PG8_WAIT_L(n) asm volatile("s_waitcnt lgkmcnt(" #n ")" ::: "memory")
#define PG8_BAR __builtin_amdgcn_s_barrier()
#define PG8_SCHED __builtin_amdgcn_sched_barrier(0)
    Unit cur, nxt; int ui = 0;
    if (!S.next(0, cur)) return;
    f32x4 acc[2][2][4][2];
#pragma unroll
    for (int a = 0; a < 2; ++a)
#pragma unroll
        for (int b = 0; b < 2; ++b)
#pragma unroll
            for (int m = 0; m < 4; ++m)
#pragma unroll
                for (int n = 0; n < 2; ++n) acc[a][b][m][n] = (f32x4){0.f, 0.f, 0.f, 0.f};
    bf16x8 At[4][2], B0[2][2], B1[2][2];
    const char* cA = (const char*)g.A + (size_t)cur.pm * tstep; const char* cB = (const char*)g.Bt + (size_t)cur.pn * tstep;
    S.a_ready(cur);
    if constexpr (SP2) {
        PG8_STAGE(PG8_SB(0, 0), cB, voffB); PG8_STAGE(PG8_SB(0, 1), cB + hstep, voffB); PG8_STAGE(PG8_SA(0, 0), cA, voffA); PG8_STAGE(PG8_SA(0, 1), cA + hstep, voffA);
        if (wr == 1) PG8_BAR;
        PG8_WAIT_V(2); PG8_BAR;
        PG8_STAGE(PG8_SB(1, 0), cB + kstep, voffB); PG8_STAGE(PG8_SA(1, 0), cA + kstep, voffA); PG8_STAGE(PG8_SB(1, 1), cB + hstep + kstep, voffB);
        PG8_WAIT_V(6); PG8_BAR;
    } else {
        PG8_STAGE(PG8_SB(0, 0), cB, voffB); PG8_STAGE(PG8_SA(0, 0), cA, voffA); PG8_STAGE(PG8_SB(0, 1), cB + hstep, voffB); PG8_STAGE(PG8_SA(0, 1), cA + hstep, voffA);
        if (wr == 1) PG8_BAR;
        PG8_WAIT_V(4); PG8_BAR;
        PG8_STAGE(PG8_SB(1, 0), cB + kstep, voffB); PG8_STAGE(PG8_SA(1, 0), cA + kstep, voffA); PG8_STAGE(PG8_SB(1, 1), cB + hstep + kstep, voffB);
        PG8_WAIT_V(6); PG8_BAR;
    }
    for (;;) {
        const bool has_next = S.next(ui + 1, nxt);
        const char* nA = has_next ? (const char*)g.A + (size_t)nxt.pm * tstep : cA; const char* nB = has_next ? (const char*)g.Bt + (size_t)nxt.pn * tstep : cB;
        for (int t = 0; t < nt; t += 2) {
            const bool last = (t == nt - 2);
            const char* a1 = cA + (size_t)(t + 1) * kstep;
            const char* a2 = last ? nA : cA + (size_t)(t + 2) * kstep; const char* b2 = last ? nB : cB + (size_t)(t + 2) * kstep;
            const char* a3 = a2 + kstep; const char* b3 = b2 + kstep;
            if (last && has_next) S.a_ready(nxt);
            if constexpr (SP2) {
            PG8_LDB(B0, 0, 0); PG8_LDB(B1, 0, 1); PG8_SCHED; PG8_LDA(At, 0, 0); PG8_STAGE(PG8_SA(1, 1), a1 + hstep, voffA);
            PG8_WAIT_V(8); PG8_WAIT_L(0); PG8_BAR; PG8_MMA(0, 0, At, B0); PG8_MMA(0, 1, At, B1); PG8_BAR; PG8_SCHED;
            PG8_LDA(At, 0, 1); PG8_STAGE(PG8_SB(0, 0), b2, voffB); PG8_STAGE(PG8_SB(0, 1), b2 + hstep, voffB); PG8_STAGE(PG8_SA(0, 0), a2, voffA);
            PG8_WAIT_V(8); PG8_WAIT_L(0); PG8_BAR; PG8_MMA(1, 0, At, B0); PG8_MMA(1, 1, At, B1); PG8_BAR; PG8_SCHED;
            PG8_LDB(B0, 1, 0); PG8_LDB(B1, 1, 1); PG8_SCHED; PG8_LDA(At, 1, 0); PG8_STAGE(PG8_SA(0, 1), a2 + hstep, voffA);
            PG8_WAIT_V(8); PG8_WAIT_L(0); PG8_BAR; PG8_MMA(0, 0, At, B0); PG8_MMA(0, 1, At, B1); PG8_BAR; PG8_SCHED;
            PG8_LDA(At, 1, 1); PG8_STAGE(PG8_SB(1, 0), b3, voffB); PG8_STAGE(PG8_SB(1, 1), b3 + hstep, voffB); PG8_STAGE(PG8_SA(1, 0), a3, voffA);
            PG8_WAIT_V(8); PG8_WAIT_L(0); PG8_BAR; PG8_MMA(1, 0, At, B0); PG8_MMA(1, 1, At, B1); PG8_BAR; PG8_SCHED;
            } else {
            PG8_LDB(B0, 0, 0); PG8_SCHED; PG8_LDA(At, 0, 0); PG8_STAGE(PG8_SA(1, 1), a1 + hstep, voffA);
            PG8_WAIT_L(8); PG8_BAR; PG8_WAIT_L(0); PG8_MMA(0, 0, At, B0); PG8_BAR; PG8_SCHED;
            PG8_LDB(B1, 0, 1); PG8_STAGE(PG8_SB(0, 0), b2, voffB);
            PG8_BAR; PG8_WAIT_L(0); PG8_MMA(0, 1, At, B1); PG8_BAR;
            PG8_LDA(At, 0, 1); PG8_STAGE(PG8_SA(0, 0), a2, voffA);
            PG8_BAR; PG8_WAIT_L(0); PG8_MMA(1, 0, At, B0); PG8_BAR; PG8_SCHED;
            PG8_STAGE(PG8_SB(0, 1), b2 + hstep, voffB);
            PG8_WAIT_V(6); PG8_BAR; PG8_MMA(1, 1, At, B1); PG8_BAR;
            PG8_LDB(B0, 1, 0); PG8_SCHED; PG8_LDA(At, 1, 0); PG8_STAGE(PG8_SA(0, 1), a2 + hstep, voffA);
            PG8_WAIT_L(8); PG8_BAR; PG8_WAIT_L(0); PG8_MMA(0, 0, At, B0); PG8_BAR; PG8_SCHED;
            PG8_LDB(B1, 1, 1); PG8_STAGE(PG8_SB(1, 0), b3, voffB);
            PG8_BAR; PG8_WAIT_L(0); PG8_MMA(0, 1, At, B1); PG8_BAR;
            PG8_LDA(At, 1, 1); PG8_STAGE(PG8_SA(1, 0), a3, voffA);
            PG8_BAR; PG8_WAIT_L(0); PG8_MMA(1, 0, At, B0); PG8_BAR; PG8_SCHED;
            PG8_STAGE(PG8_SB(1, 1), b3 + hstep, voffB);
            PG8_WAIT_V(6); PG8_BAR; PG8_MMA(1, 1, At, B1); PG8_BAR;
            }
        }
        if constexpr (ALIGN_EPI) { if (wr == 0) PG8_BAR; }
        if constexpr (!Epi::AFTER_DRAIN) { E(acc, cur, wr, wc, fr, fq); S.done(cur); }
        if (!has_next) break;
#pragma unroll
        for (int a = 0; a < 2; ++a)
#pragma unroll
            for (int b = 0; b < 2; ++b)
#pragma unroll
                for (int m = 0; m < 4; ++m)
#pragma unroll
                    for (int n = 0; n < 2; ++n) acc[a][b][m][n] = (f32x4){0.f, 0.f, 0.f, 0.f};
        cur = nxt; cA = nA; cB = nB; ++ui;
        if constexpr (ALIGN_EPI) { if (wr == 1) PG8_BAR; }
    }
    PG8_WAIT_V(0);
    if constexpr (!ALIGN_EPI) { if (wr == 0) PG8_BAR; }
    PG8_BAR;
    if constexpr (Epi::AFTER_DRAIN) { E.fused(acc, cur, wr, wc, fr, fq, lds, wid, lane); S.done(cur); }
#undef PG8_SA
#undef PG8_SB
#undef PG8_STAGE
#undef PG8_LDA
#undef PG8_LDB
#undef PG8_MMA
#undef PG8_WAIT_V
#undef PG8_WAIT_L
#undef PG8_BAR
#undef PG8_SCHED
}
}
namespace fk {
using pg8::bf16_t; using pg8::f32x4; using pg8::u32x4; using pg8::Unit; using pg8::bf16x8;
typedef float f32x2 __attribute__((ext_vector_type(2)));
typedef unsigned u32x2 __attribute__((ext_vector_type(2)));
#define LAS __attribute__((address_space(3)))
#ifndef FK_NB
#define FK_NB 4
#endif
constexpr int NB = FK_NB, D = 1024, SEQ = 8192, T = NB * SEQ, H = 16;
constexpr int F = 2816, F2 = 5632, RIN = 6144, RV = 2048;
constexpr float ALPHA = 1.4142135623730951f, LN_EPS = 1e-5f, GN_EPS = 1e-5f;
constexpr float LOG2E = 1.4426950408889634f, C2 = 0.125f * LOG2E;
constexpr size_t MiB = 1u << 20;
constexpr size_t WS_CTL = 0, CTL_ZERO_BYTES = 65536;
constexpr size_t WS_WQKV = 1 * MiB, WS_WAO = 7 * MiB, WS_WRI = 9 * MiB, WS_WRO = 21 * MiB, WS_WUP0 = 25 * MiB, WS_WUP1 = 36 * MiB, WS_WDN0 = 47 * MiB, WS_WDN1 = 52 * MiB + 512 * 1024;
constexpr size_t WS_KMEAN = 58 * MiB, WS_CNT = 59 * MiB;
constexpr size_t SLOT = (size_t)16 * NB * MiB, WS_A = 64 * MiB, WS_B = WS_A + SLOT, WS_C = WS_B + SLOT, WS_D = WS_C + SLOT, WS_E = WS_D + SLOT, WS_F = WS_E + SLOT, WS_G = WS_F + SLOT, WS_END = WS_G + SLOT;
constexpr size_t WS_LISTS = WS_END - (size_t)4 * NB * MiB;
constexpr size_t WS_PART = WS_D;
constexpr size_t WS_UBUF0 = WS_F + (size_t)12 * NB * MiB;
constexpr size_t WS_UBUF1 = WS_A;
constexpr int CW_BAR = 4096;

__device__ __forceinline__ unsigned f2bf(float f) { unsigned u = __builtin_bit_cast(unsigned, f); return (u + 0x7fffu + ((u >> 16) & 1u)) >> 16; }
__device__ __forceinline__ unsigned pk2(float lo, float hi) { return f2bf(lo) | (f2bf(hi) << 16); }
__device__ __forceinline__ float bf2f(unsigned short b) { return __builtin_bit_cast(float, (unsigned)b << 16); }
__device__ __forceinline__ float ror1(float v) { return __builtin_bit_cast(float, __builtin_amdgcn_mov_dpp(__builtin_bit_cast(int, v), 0x121, 0xf, 0xf, false)); }
__device__ __forceinline__ float ror2(float v) { return __builtin_bit_cast(float, __builtin_amdgcn_mov_dpp(__builtin_bit_cast(int, v), 0x122, 0xf, 0xf, false)); }

struct EpiRetIn {
    static constexpr bool PERM = true, AFTER_DRAIN = false;
    bf16_t *q, *k, *v, *g;
    __device__ __forceinline__ void operator()(const f32x4 (&acc)[2][2][4][2], const Unit& u, int wr, int wc, int fr, int fq) const {
        bf16_t* base; int ldc, colt; float sc = 1.f; bool act = false;
        if (u.pn < 4) { base = q; ldc = 1024; colt = u.pn * 256; }
        else if (u.pn < 8) { base = k; ldc = 1024; colt = (u.pn - 4) * 256; sc = 0.0625f; }
        else if (u.pn < 16) { base = v; ldc = 2048; colt = (u.pn - 8) * 256; }
        else { base = g; ldc = 2048; colt = (u.pn - 16) * 256; act = true; }
        const int row0 = u.pm * 256 + wr * 64 + fr, col0 = colt + wc * 32 + 8 * fq;
#pragma unroll
        for (int ai = 0; ai < 2; ++ai)
#pragma unroll
            for (int m = 0; m < 4; ++m) { bf16_t* rowp = base + (size_t)(row0 + ai * 128 + m * 16) * ldc + col0;
#pragma unroll
                for (int bj = 0; bj < 2; ++bj) { f32x4 v0 = acc[ai][bj][m][0] * sc, v1 = acc[ai][bj][m][1] * sc;
                    if (act) {
#pragma unroll
                        for (int e = 0; e < 4; ++e) { v0[e] = v0[e] * __builtin_amdgcn_rcpf(1.f + __builtin_amdgcn_exp2f(-LOG2E * v0[e])); v1[e] = v1[e] * __builtin_amdgcn_rcpf(1.f + __builtin_amdgcn_exp2f(-LOG2E * v1[e])); } }
                    u32x4 w; w.x = pg8::cvt_pk_bf16(v0[0], v0[1]); w.y = pg8::cvt_pk_bf16(v0[2], v0[3]); w.z = pg8::cvt_pk_bf16(v1[0], v1[1]); w.w = pg8::cvt_pk_bf16(v1[2], v1[3]);
                    *(u32x4*)(rowp + bj * 128) = w; } }
    }
};
struct EpiResid {
    static constexpr bool PERM = false, AFTER_DRAIN = false;
    const float* base; float* out;
    __device__ __forceinline__ void operator()(const f32x4 (&acc)[2][2][4][2], const Unit& u, int wr, int wc, int fr, int fq) const {
        const int col0 = u.pn * 256 + wc * 32 + 4 * fq;
#pragma unroll
        for (int ai = 0; ai < 2; ++ai)
#pragma unroll
            for (int m = 0; m < 4; ++m) { const size_t off = (size_t)(u.pm * 256 + ai * 128 + wr * 64 + m * 16 + fr) * 1024 + col0;
#pragma unroll
                for (int bj = 0; bj < 2; ++bj)
#pragma unroll
                    for (int n = 0; n < 2; ++n) { const f32x4 bs = *(const f32x4*)(base + off + bj * 128 + n * 16); *(f32x4*)(out + off + bj * 128 + n * 16) = bs * ALPHA + acc[ai][bj][m][n]; } }
    }
};
struct EpiUp {
    static constexpr bool PERM = true, AFTER_DRAIN = false;
    bf16_t* G; const float* cw; const float* cb; float* ubuf;
    __device__ __forceinline__ void operator()(const f32x4 (&acc)[2][2][4][2], const Unit& u, int wr, int wc, int fr, int fq) const {
        const int chA = u.pn * 128 + wc * 32 + 8 * fq;
        u32x2 keep[2][4];
#pragma unroll
        for (int n = 0; n < 2; ++n) {
            const int c = chA + 4 * n;
            const f32x4 a0 = *(const f32x4*)(cw + c), a1 = *(const f32x4*)(cw + F2 + c), a2 = *(const f32x4*)(cw + 2 * F2 + c), ab = *(const f32x4*)(cb + c);
            const f32x4 g0 = *(const f32x4*)(cw + F + c), g1 = *(const f32x4*)(cw + F2 + F + c), g2 = *(const f32x4*)(cw + 2 * F2 + F + c), gb = *(const f32x4*)(cb + F + c);
#pragma unroll
            for (int ai = 0; ai < 2; ++ai) {
                const int strip = u.pm * 4 + ai * 2 + wr;
                f32x4 pa = acc[ai][0][0][n], pg = acc[ai][1][0][n];
#pragma unroll
                for (int m = 0; m < 4; ++m) {
                    const f32x4 ua = acc[ai][0][m][n], ug = acc[ai][1][m][n];
                    f32x4 ha, hg;
#pragma unroll
                    for (int e = 0; e < 4; ++e) {
                        const float ya1 = ror1(fr == 15 ? pa[e] : ua[e]), ya2 = ror2(fr >= 14 ? pa[e] : ua[e]);
                        const float yg1 = ror1(fr == 15 ? pg[e] : ug[e]), yg2 = ror2(fr >= 14 ? pg[e] : ug[e]);
                        ha[e] = ab[e] + a2[e] * ua[e] + a1[e] * ya1 + a0[e] * ya2;
                        hg[e] = gb[e] + g2[e] * ug[e] + g1[e] * yg1 + g0[e] * yg2;
                    }
                    const f32x2 x0 = pg8::gelu_pk((f32x2){ha[0], ha[1]}), x1 = pg8::gelu_pk((f32x2){ha[2], ha[3]});
                    u32x2 w; w.x = pg8::cvt_pk_bf16(x0.x * hg[0], x0.y * hg[1]); w.y = pg8::cvt_pk_bf16(x1.x * hg[2], x1.y * hg[3]);
                    const int row = u.pm * 256 + ai * 128 + wr * 64 + m * 16 + fr;
                    if (n == 0) keep[ai][m] = w;
                    else if (!(m == 0 && fr < 2)) { u32x4 o; o.x = keep[ai][m].x; o.y = keep[ai][m].y; o.z = w.x; o.w = w.y; *(u32x4*)(G + (size_t)row * F + chA) = o; }
                    if (m == 0 && fr < 2) { float* ub = ubuf + ((size_t)strip * 4 + fr) * F2; *(f32x4*)(ub + c) = ua; *(f32x4*)(ub + F + c) = ug; }
                    if (m == 3 && fr >= 14) { float* ub = ubuf + ((size_t)strip * 4 + 2 + (fr - 14)) * F2; *(f32x4*)(ub + c) = ua; *(f32x4*)(ub + F + c) = ug; }
                    pa = ua; pg = ug;
                }
            }
        }
    }
};

#define XB_TMO      128
#define XB_XCNT(j)  (256  + 64 * (j))
#define XB_XSUB(j)  (1280 + 64 * (j))
#define XB_XGEN(j)  (2304 + 64 * (j))
#define XB_TOP      3328
#define XB_TOPGEN   3392
#define XCD_BAR_WORDS 3456
#define XB_SPIN_CAP (1u << 18)
__device__ __forceinline__ unsigned xb_ld(unsigned* p)              { return __hip_atomic_load(p, __ATOMIC_RELAXED, __HIP_MEMORY_SCOPE_AGENT); }
__device__ __forceinline__ unsigned xb_add(unsigned* p, unsigned v) { return __hip_atomic_fetch_add(p, v, __ATOMIC_RELAXED, __HIP_MEMORY_SCOPE_AGENT); }
__device__ __forceinline__ unsigned xb_xcc_id() { return (unsigned)__builtin_amdgcn_s_getreg((3 << 11) | 20) & 0xFu; }
#define XB_SPIN(cond, bar) do { unsigned _sp = 0; while (cond) { __builtin_amdgcn_s_sleep(1); \
    if ((++_sp & 255u) == 0u) { if (xb_ld(&(bar)[XB_TMO])) break; if (_sp > XB_SPIN_CAP) { atomicAdd(&(bar)[XB_TMO], 1u); break; } } } } while (0)
struct XcdBarrier { unsigned* bar; unsigned x; volatile LAS unsigned* st; };
__device__ __forceinline__ XcdBarrier xcd_barrier_post(unsigned* bar, volatile LAS unsigned* st) {
    XcdBarrier b; b.bar = bar; b.x = xb_xcc_id(); b.st = st;
    if (threadIdx.x == 0) (void)xb_add(&bar[XB_XCNT(b.x)], 1u);
    return b;
}
__device__ __forceinline__ void xcd_barrier_complete(unsigned* bar, unsigned x, unsigned& nloc, unsigned& nx) {
    const unsigned G = gridDim.x * gridDim.y * gridDim.z;
    unsigned sum, cnt, mine, sp = 0u;
    for (;;) {
        sum = 0u; cnt = 0u; mine = 0u;
#pragma unroll
        for (unsigned j = 0; j < 16; ++j) { const unsigned c = xb_ld(&bar[XB_XCNT(j)]); sum += c; cnt += (c > 0u) ? 1u : 0u; mine = (j == x) ? c : mine; }
        if (sum == G) break;
        __builtin_amdgcn_s_sleep(1);
        if ((++sp & 255u) == 0u) { if (xb_ld(&bar[XB_TMO])) break; if (sp > XB_SPIN_CAP) { atomicAdd(&bar[XB_TMO], 1u); break; } }
    }
    nloc = mine > 0u ? mine : 1u; nx = cnt > 0u ? cnt : 1u;
}
__device__ __forceinline__ void xcd_barrier(const XcdBarrier& b) {
    asm volatile("s_waitcnt vmcnt(0)" ::: "memory");
    __syncthreads();
    if (threadIdx.x == 0) {
        unsigned* bar = b.bar;
        __builtin_amdgcn_s_waitcnt(0);
        unsigned nloc = b.st[0], nx = b.st[1];
        if (nloc == 0u) { xcd_barrier_complete(bar, b.x, nloc, nx); b.st[0] = nloc; b.st[1] = nx; }
        const unsigned old = xb_add(&bar[XB_XSUB(b.x)], 1u);
        const unsigned gen = old / nloc;
        if (old + 1u == (gen + 1u) * nloc) {
            __builtin_amdgcn_fence(__ATOMIC_RELEASE, "agent");
            asm volatile("s_waitcnt vmcnt(0)" ::: "memory");
            const unsigned og = xb_add(&bar[XB_TOP], 1u);
            const unsigned tg = og / nx;
            if (og + 1u == (tg + 1u) * nx) xb_add(&bar[XB_TOPGEN], 1u);
            else XB_SPIN(xb_ld(&bar[XB_TOPGEN]) == tg, bar);
            __builtin_amdgcn_fence(__ATOMIC_ACQUIRE, "agent");
            xb_add(&bar[XB_XGEN(b.x)], 1u);
            asm volatile("s_waitcnt vmcnt(0)" ::: "memory");
        } else {
            XB_SPIN(xb_ld(&bar[XB_XGEN(b.x)]) == gen, bar);
            __builtin_amdgcn_fence(__ATOMIC_ACQUIRE, "agent");
            asm volatile("s_waitcnt vmcnt(0)" ::: "memory");
        }
    }
    __syncthreads();
}

__device__ __forceinline__ float wave_sum(float v) {
#pragma unroll
    for (int o = 1; o < 64; o <<= 1) v += __shfl_xor(v, o);
    return v;
}
template <int MODE  >
__device__ __forceinline__ void transpose_item(const float* W, int K, int N, bf16_t* WT, LAS float* scr, int item, int lane) {
    const int nblk = N / 32, kb = item / nblk, nb = item % nblk, k0 = 64 * kb, n0 = 32 * nb;
    int r0 = n0;
    if (MODE == 1) r0 = (n0 < F) ? (n0 / 128) * 256 + (n0 % 128) : ((n0 - F) / 128) * 256 + 128 + ((n0 - F) % 128);
#pragma unroll 8
    for (int i = 0; i < 32; ++i) { const int kk = 2 * i + (lane >> 5); scr[kk * 33 + (lane & 31)] = W[(size_t)(k0 + kk) * N + n0 + (lane & 31)]; }
    asm volatile("s_waitcnt lgkmcnt(0)" ::: "memory");
    const int c = lane & 7;
#pragma unroll
    for (int j = 0; j < 4; ++j) { const int n = (lane >> 3) + 8 * j; const LAS float* s = scr + (8 * c) * 33 + n;
        u32x4 o; o.x = pk2(s[0 * 33], s[1 * 33]); o.y = pk2(s[2 * 33], s[3 * 33]); o.z = pk2(s[4 * 33], s[5 * 33]); o.w = pk2(s[6 * 33], s[7 * 33]);
        *(u32x4*)(WT + (size_t)(r0 + n) * K + k0 + 8 * c) = o; }
    asm volatile("s_waitcnt lgkmcnt(0)" ::: "memory");
}
__device__ __forceinline__ void ln_phase(const float* z, const float* g, const float* b, float* xo, bf16_t* xbo, int gw, int ngw, int lane) {
    f32x4 gg[4], bb[4];
#pragma unroll
    for (int j = 0; j < 4; ++j) { gg[j] = ((const f32x4*)g)[lane + 64 * j]; bb[j] = ((const f32x4*)b)[lane + 64 * j]; }
    for (int r = gw; r < T; r += ngw) {
        const f32x4* zr = (const f32x4*)(z + (size_t)r * D) + lane; f32x4 v[4]; float s = 0.f;
#pragma unroll
        for (int j = 0; j < 4; ++j) { v[j] = zr[64 * j]; s += (v[j][0] + v[j][1]) + (v[j][2] + v[j][3]); }
        const float mean = wave_sum(s) * (1.f / D); float s2 = 0.f;
#pragma unroll
        for (int j = 0; j < 4; ++j) { v[j] = v[j] - mean; s2 += (v[j][0] * v[j][0] + v[j][1] * v[j][1]) + (v[j][2] * v[j][2] + v[j][3] * v[j][3]); }
        const float rstd = 1.f / sqrtf(wave_sum(s2) * (1.f / D) + LN_EPS);
        f32x4* xr = (f32x4*)(xo + (size_t)r * D) + lane;
#pragma unroll
        for (int j = 0; j < 4; ++j) { v[j] = v[j] * rstd * gg[j] + bb[j]; xr[64 * j] = v[j]; }
        if (xbo) { u32x2* o8 = (u32x2*)(xbo + (size_t)r * D) + lane;
#pragma unroll
            for (int j = 0; j < 4; ++j) { u32x2 w; w.x = pk2(v[j][0], v[j][1]); w.y = pk2(v[j][2], v[j][3]); o8[64 * j] = w; } }
    }
}
__device__ __forceinline__ float gelu_exact(float a) { const f32x2 r = pg8::gelu_pk((f32x2){a, a}); return r.x; }
__device__ __forceinline__ void fixup_phase(const float* ubuf, const float* cw, const float* cb, bf16_t* G, int gtid, int ngt) {
    const int total = (T / 64) * 2 * (F / 4);
    for (int i = gtid; i < total; i += ngt) {
        const int c = (i % (F / 4)) * 4, rr = (i / (F / 4)) & 1, sg = i / (F / 2);
        const bool ss = (sg % (SEQ / 64)) == 0;
        const float* ub = ubuf + (size_t)sg * 4 * F2; const float* up = ub - (size_t)4 * F2;
        f32x4 res;
#pragma unroll
        for (int half = 0; half < 2; ++half) {
            const int cc = c + half * F; const f32x4 z4 = {0.f, 0.f, 0.f, 0.f};
            const f32x4 u0 = *(const f32x4*)(ub + (size_t)rr * F2 + cc);
            const f32x4 um1 = rr == 1 ? *(const f32x4*)(ub + cc) : (ss ? z4 : *(const f32x4*)(up + (size_t)3 * F2 + cc));
            const f32x4 um2 = rr == 1 ? (ss ? z4 : *(const f32x4*)(up + (size_t)3 * F2 + cc)) : (ss ? z4 : *(const f32x4*)(up + (size_t)2 * F2 + cc));
            const f32x4 h = *(const f32x4*)(cb + cc) + *(const f32x4*)(cw + 2 * F2 + cc) * u0 + *(const f32x4*)(cw + F2 + cc) * um1 + *(const f32x4*)(cw + cc) * um2;
            if (half == 0) { res[0] = gelu_exact(h[0]); res[1] = gelu_exact(h[1]); res[2] = gelu_exact(h[2]); res[3] = gelu_exact(h[3]); } else res = res * h;
        }
        u32x2 w; w.x = pk2(res[0], res[1]); w.y = pk2(res[2], res[3]);
        *(u32x2*)(G + (size_t)(sg * 64 + rr) * F + c) = w;
    }
}
}
#define FK_HAVE_ATTN 1
namespace fk {
typedef float f32x16 __attribute__((ext_vector_type(16)));
typedef short s16x4 __attribute__((ext_vector_type(4)));
typedef __bf16 bf16x2_t __attribute__((ext_vector_type(2)));
constexpr int NBH = NB * H, NBLK = 32;
constexpr int LIST_PER_BH = 126976;
constexpr float NEG_BIG = -3.0e38f;
__device__ __forceinline__ int crow(int r, int h) { return (r & 3) + 8 * (r >> 2) + 4 * h; }
__device__ __forceinline__ unsigned cvtpk(float lo, float hi) { f32x2 v = {lo, hi}; bf16x2_t b = __builtin_convertvector(v, bf16x2_t); return __builtin_bit_cast(unsigned, b); }
__device__ __forceinline__ int segbase(int n) { return 256 * (31 * n - (n * (n - 1)) / 2); }
#define MFMA32(a, b, c) __builtin_amdgcn_mfma_f32_32x32x16_bf16((a), (b), (c), 0, 0, 0)
typedef short v4i16_t __attribute__((ext_vector_type(4)));
__device__ __forceinline__ s16x4 tr_read(LAS const unsigned char* p) { return __builtin_bit_cast(s16x4, __builtin_amdgcn_ds_read_tr16_b64_v4i16((LAS v4i16_t*)p)); }

__device__ __forceinline__ void attn_kmean_phase(unsigned char* ws, LAS unsigned char*, int gw, int ngw, int lane) {
    const bf16_t* K = (const bf16_t*)(ws + WS_B); float* km = (float*)(ws + WS_KMEAN);
    for (int u = gw; u < NBH * NBLK; u += ngw) {
        const int bh = u >> 5, n = u & 31, b = bh >> 4, h = bh & 15;
        const bf16_t* p = K + (size_t)(b * SEQ + n * 256) * D + h * 64 + lane; float s = 0.f;
#pragma unroll 8
        for (int r = 0; r < 256; ++r) s += bf2f(p[(size_t)r * D]);
        km[(size_t)u * 64 + lane] = s * (1.f / 256.f);
    }
}
__device__ __forceinline__ void attn_gate_phase(unsigned char* ws, LAS unsigned char* lds, int vcu, int G, int tid) {
    const bf16_t* Q = (const bf16_t*)(ws + WS_A); const float* km = (const float*)(ws + WS_KMEAN);
    unsigned short* cnt = (unsigned short*)(ws + WS_CNT); unsigned short* lists = (unsigned short*)(ws + WS_LISTS);
    LAS float* kml = (LAS float*)lds;
    LAS unsigned* wcnt = (LAS unsigned*)(lds + 8192);
    const int lane = tid & 63, wave = tid >> 6, half = tid >> 8, qi = tid & 255, w4 = wave & 3;
    for (int u = vcu; u < NBH * 16; u += G) {
        const int bh = u >> 4, jp = u & 15, b = bh >> 4, h = bh & 15, j = 2 * jp + half, t = j * 256 + qi;
        __syncthreads();
        *(LAS f32x4*)(kml + tid * 4) = *(const f32x4*)(km + (size_t)bh * 2048 + tid * 4);
        __syncthreads();
        float q[64];
        { const u32x4* qp = (const u32x4*)(Q + (size_t)(b * SEQ + t) * D + h * 64);
#pragma unroll
          for (int c = 0; c < 8; ++c) { const u32x4 w = qp[c];
              q[8 * c + 0] = __builtin_bit_cast(float, w.x << 16); q[8 * c + 1] = __builtin_bit_cast(float, w.x & 0xffff0000u);
              q[8 * c + 2] = __builtin_bit_cast(float, w.y << 16); q[8 * c + 3] = __builtin_bit_cast(float, w.y & 0xffff0000u);
              q[8 * c + 4] = __builtin_bit_cast(float, w.z << 16); q[8 * c + 5] = __builtin_bit_cast(float, w.z & 0xffff0000u);
              q[8 * c + 6] = __builtin_bit_cast(float, w.w << 16); q[8 * c + 7] = __builtin_bit_cast(float, w.w & 0xffff0000u); } }
        float v0 = -INFINITY, v1 = -INFINITY, v2 = -INFINITY; int i0 = 0, i1 = 0, i2 = 0;
        for (int n = 0; n < j; ++n) {
            float g = 0.f;
#pragma unroll
            for (int d4 = 0; d4 < 16; ++d4) { const f32x4 kv = *(LAS const f32x4*)(kml + n * 64 + d4 * 4); g = fmaf(q[4 * d4], kv[0], g); g = fmaf(q[4 * d4 + 1], kv[1], g); g = fmaf(q[4 * d4 + 2], kv[2], g); g = fmaf(q[4 * d4 + 3], kv[3], g); }
            if (g > v0) { v2 = v1; i2 = i1; v1 = v0; i1 = i0; v0 = g; i0 = n; }
            else if (g > v1) { v2 = v1; i2 = i1; v1 = g; i1 = n; }
            else if (g > v2) { v2 = g; i2 = n; }
        }
        const int nsel = j < 3 ? j : 3;
        for (int n = 0; n < j; ++n) {
            const bool fl = (nsel > 0 && i0 == n) || (nsel > 1 && i1 == n) || (nsel > 2 && i2 == n);
            const unsigned long long mk = __ballot(fl);
            if (lane == 0) wcnt[(half * 32 + n) * 4 + w4] = (unsigned)__popcll(mk);
        }
        __syncthreads();
        for (int n = 0; n < j; ++n) {
            const int rk = (nsel > 0 && i0 == n) ? 0 : (nsel > 1 && i1 == n) ? 1 : (nsel > 2 && i2 == n) ? 2 : -1;
            const unsigned long long mk = __ballot(rk >= 0);
            if (rk >= 0) {
                unsigned base = 0;
                for (int w = 0; w < w4; ++w) base += wcnt[(half * 32 + n) * 4 + w];
                const unsigned pos = base + (unsigned)__popcll(mk & ((1ull << lane) - 1ull));
                lists[(size_t)bh * LIST_PER_BH + segbase(n) + (j - n - 1) * 256 + pos] = (unsigned short)(t | (rk << 13));
            }
        }
        if (qi < j) cnt[(bh * 32 + qi) * 32 + j] = (unsigned short)(wcnt[(half * 32 + qi) * 4 + 0] + wcnt[(half * 32 + qi) * 4 + 1] + wcnt[(half * 32 + qi) * 4 + 2] + wcnt[(half * 32 + qi) * 4 + 3]);
    }
}
__device__ __forceinline__ void stage_kv(const bf16_t* Kg, const bf16_t* Vg, LAS unsigned char* kl, LAS unsigned char* vl, int tid) {
#pragma unroll
    for (int i = 0; i < 4; ++i) { const int idx = tid + 512 * i, key = idx >> 3, c = idx & 7;
        const u32x4 kv = *(const u32x4*)(Kg + (size_t)key * D + c * 8); *(LAS u32x4*)(kl + key * 128 + ((c ^ ((key >> 1) & 7)) << 4)) = kv;
        const u32x4 vv = *(const u32x4*)(Vg + (size_t)key * D + c * 8); *(LAS u32x4*)(vl + (key >> 3) * 1024 + (c >> 2) * 512 + (key & 7) * 64 + (c & 3) * 16) = vv; }
}
template <bool CAUSAL>
__device__ __forceinline__ void attn_tile(const bf16x8 (&qf)[4], int tq, int kpos0, float slope2, int nkt, LAS const unsigned char* kl, LAS const unsigned char* vl, int lane, float& m_out, float& l_out, f32x16& o0, f32x16& o1) {
    const int r = lane & 31, h = lane >> 5;
    const int i16 = lane & 15, g = (lane >> 4) & 1;
    LAS const unsigned char* vb = vl + (4 * h + (i16 >> 2)) * 64 + (16 * g + 4 * (i16 & 3)) * 2;
    float m = NEG_BIG, l = 0.f;
#pragma unroll
    for (int i = 0; i < 16; ++i) { o0[i] = 0.f; o1[i] = 0.f; }
#pragma unroll
    for (int grp = 0; grp < 2; ++grp) {
        if (4 * grp < nkt) {
            f32x16 s[4];
            float gm = NEG_BIG;
#pragma unroll
            for (int k4 = 0; k4 < 4; ++k4) {
                const int kt = 4 * grp + k4;
                if (kt < nkt) {
                    f32x16 acc;
#pragma unroll
                    for (int i = 0; i < 16; ++i) acc[i] = 0.f;
                    const int key = 32 * kt + r;
#pragma unroll
                    for (int d0 = 0; d0 < 4; ++d0) { const bf16x8 kf = *(LAS const bf16x8*)(kl + key * 128 + (((2 * d0 + h) ^ ((key >> 1) & 7)) << 4)); acc = MFMA32(kf, qf[d0], acc); }
                    const int ib = kpos0 + 32 * kt + 4 * h - tq;
#pragma unroll
                    for (int i = 0; i < 16; ++i) acc[i] = fmaf(slope2, (float)(ib + (i & 3) + 8 * (i >> 2)), acc[i]);
                    if (CAUSAL && kt == nkt - 1) {
#pragma unroll
                        for (int i = 0; i < 16; ++i) if (crow(i, h) > r) acc[i] = NEG_BIG;
                    }
#pragma unroll
                    for (int i = 0; i < 16; ++i) gm = fmaxf(gm, acc[i]);
                    s[k4] = acc;
                }
            }
            gm = fmaxf(gm, __shfl_xor(gm, 32));
            const float mn = fmaxf(m, gm), corr = __builtin_amdgcn_exp2f(m - mn);
            l *= corr;
#pragma unroll
            for (int i = 0; i < 16; ++i) { o0[i] *= corr; o1[i] *= corr; }
            m = mn;
#pragma unroll
            for (int k4 = 0; k4 < 4; ++k4) {
                const int kt = 4 * grp + k4;
                if (kt < nkt) {
#pragma unroll
                    for (int i = 0; i < 16; ++i) { const float p = __builtin_amdgcn_exp2f(s[k4][i] - mn); s[k4][i] = p; l += p; }
#pragma unroll
                    for (int st = 0; st < 2; ++st) {
                        u32x4 pw; pw.x = cvtpk(s[k4][8 * st + 0], s[k4][8 * st + 1]); pw.y = cvtpk(s[k4][8 * st + 2], s[k4][8 * st + 3]); pw.z = cvtpk(s[k4][8 * st + 4], s[k4][8 * st + 5]); pw.w = cvtpk(s[k4][8 * st + 6], s[k4][8 * st + 7]);
                        const bf16x8 pf = __builtin_bit_cast(bf16x8, pw);
                        LAS const unsigned char* vp = vb + ((32 * kt + 16 * st) >> 3) * 1024;
                        { const s16x4 lo = tr_read(vp), hi = tr_read(vp + 1024); const bf16x8 vf = __builtin_shufflevector(lo, hi, 0, 1, 2, 3, 4, 5, 6, 7); o0 = MFMA32(vf, pf, o0); }
                        { const s16x4 lo = tr_read(vp + 512), hi = tr_read(vp + 512 + 1024); const bf16x8 vf = __builtin_shufflevector(lo, hi, 0, 1, 2, 3, 4, 5, 6, 7); o1 = MFMA32(vf, pf, o1); }
                    }
                }
            }
        }
    }
    l += __shfl_xor(l, 32);
    m_out = m; l_out = l;
}
__device__ __forceinline__ void load_qf(bf16x8 (&qf)[4], const bf16_t* qrow, int h) {
#pragma unroll
    for (int d0 = 0; d0 < 4; ++d0) qf[d0] = *(const bf16x8*)(qrow + d0 * 16 + h * 8);
}
__device__ __forceinline__ void attn_sel_phase(unsigned char* ws, LAS unsigned char* lds, int vcu, int G, int tid) {
    const bf16_t* Q = (const bf16_t*)(ws + WS_A); const bf16_t* K = (const bf16_t*)(ws + WS_B); const bf16_t* V = (const bf16_t*)(ws + WS_C);
    const unsigned short* cnt = (const unsigned short*)(ws + WS_CNT); const unsigned short* lists = (const unsigned short*)(ws + WS_LISTS);
    bf16_t* PO = (bf16_t*)(ws + WS_PART); float* PML = (float*)(ws + WS_PART + (size_t)T * H * 3 * 128);
    LAS unsigned char* kl = lds; LAS unsigned char* vl = lds + 32768;
    LAS unsigned* istart = (LAS unsigned*)(lds + 65536);
    LAS unsigned* tots = (LAS unsigned*)(lds + 65536 + 16384);
    LAS unsigned* pre = (LAS unsigned*)(lds + 65536 + 32768);
    LAS unsigned short* slot = (LAS unsigned short*)(lds + 65536 + 32768 + 256);
    LAS unsigned* scan = (LAS unsigned*)(lds + 65536 + 32768 + 1024);
    constexpr int NPAIR = NBH * 31;
    const int lane = tid & 63, wave = tid >> 6;
    constexpr int PPT = (NPAIR + 511) / 512;
    unsigned mysum = 0;
    for (int k = 0; k < PPT; ++k) { const int p = tid * PPT + k; unsigned tt = 0;
        if (p < NPAIR) { const int n = p / NBH, bh = p % NBH; for (int j = n + 1; j < 32; ++j) tt += cnt[(bh * 32 + n) * 32 + j]; tots[p] = tt; mysum += (tt + 255) >> 8; } }
    scan[tid] = mysum; __syncthreads();
    for (int o = 1; o < 512; o <<= 1) { const unsigned v = tid >= o ? scan[tid - o] : 0u; __syncthreads(); scan[tid] += v; __syncthreads(); }
    { unsigned run = scan[tid] - mysum; for (int k = 0; k < PPT; ++k) { const int p = tid * PPT + k; if (p < NPAIR) { istart[p] = run; run += (tots[p] + 255) >> 8; } } if (tid == 511) istart[NPAIR] = scan[511]; }
    __syncthreads();
    const unsigned nitems = istart[NPAIR];
    for (unsigned it = vcu; it < nitems; it += G) {
        int lo = 0, hi = NPAIR;
        while (hi - lo > 1) { const int mid = (lo + hi) >> 1; if (istart[mid] <= it) lo = mid; else hi = mid; }
        const int p = lo, n = p / NBH, bh = p % NBH, b = bh >> 4, h = bh & 15, c = (int)(it - istart[p]);
        const unsigned total = tots[p];
        __syncthreads();
        stage_kv(K + (size_t)(b * SEQ + n * 256) * D + h * 64, V + (size_t)(b * SEQ + n * 256) * D + h * 64, kl, vl, tid);
        if (wave == 0) { const int j = lane; unsigned v = (j > n && j < 32) ? cnt[(bh * 32 + n) * 32 + j] : 0u, inc = v;
#pragma unroll
            for (int o = 1; o < 32; o <<= 1) { const unsigned up = __shfl_up(inc, o); if ((lane & 31) >= o) inc += up; }
            if (lane < 32) pre[lane] = inc - v; }
        __syncthreads();
        if (tid < 256) { const unsigned gpos = 256u * c + tid; unsigned short e = 0xffffu;
            if (gpos < total) { int j = n + 1; while (j < 31 && pre[j + 1] <= gpos) ++j; e = lists[(size_t)bh * LIST_PER_BH + segbase(n) + (j - n - 1) * 256 + (gpos - pre[j])]; }
            slot[tid] = e; }
        __syncthreads();
        if (256u * c + 32u * wave < total) {
            const int r = lane & 31, hh = lane >> 5; const unsigned short e = slot[32 * wave + r]; const bool valid = e != 0xffffu;
            const int tq = valid ? (e & 0x1fff) : (n * 256 + 255), rk = e >> 13;
            bf16x8 qf[4]; load_qf(qf, Q + (size_t)(b * SEQ + tq) * D + h * 64, hh);
            const float slope2 = LOG2E * __builtin_amdgcn_exp2f(-0.5f * (float)(h + 1));
            float m, l; f32x16 o0, o1;
            attn_tile<false>(qf, tq, n * 256, slope2, 8, kl, vl, lane, m, l, o0, o1);
            if (valid) {
                const size_t sidx = ((size_t)(b * SEQ + tq) * H + h) * 3 + rk; const float il = 1.f / l;
                bf16_t* po = PO + sidx * 64;
#pragma unroll
                for (int gq = 0; gq < 4; ++gq) { u32x2 w0, w1; w0.x = cvtpk(o0[4 * gq] * il, o0[4 * gq + 1] * il); w0.y = cvtpk(o0[4 * gq + 2] * il, o0[4 * gq + 3] * il);
                    w1.x = cvtpk(o1[4 * gq] * il, o1[4 * gq + 1] * il); w1.y = cvtpk(o1[4 * gq + 2] * il, o1[4 * gq + 3] * il);
                    *(u32x2*)(po + 8 * gq + 4 * hh) = w0; *(u32x2*)(po + 32 + 8 * gq + 4 * hh) = w1; }
                if (hh == 0) { f32x2 ml = {m, l}; *(f32x2*)(PML + sidx * 2) = ml; }
            }
        }
    }
}
__device__ __forceinline__ void attn_own_phase(unsigned char* ws, LAS unsigned char* lds, int vcu, int G, int tid) {
    bf16_t* Q = (bf16_t*)(ws + WS_A); const bf16_t* K = (const bf16_t*)(ws + WS_B); const bf16_t* V = (const bf16_t*)(ws + WS_C);
    const bf16_t* PO = (const bf16_t*)(ws + WS_PART); const float* PML = (const float*)(ws + WS_PART + (size_t)T * H * 3 * 128);
    const int lane = tid & 63, wave = __builtin_amdgcn_readfirstlane(tid >> 6), r = lane & 31, hh = lane >> 5;
    for (int u = vcu; u < NBH * 16; u += G) {
        const int bh = u >> 4, jj = u & 15, b = bh >> 4, h = bh & 15;
        __syncthreads();
#pragma unroll
        for (int k2 = 0; k2 < 2; ++k2) { const size_t ro = (size_t)(b * SEQ + (2 * jj + k2) * 256) * D + h * 64; stage_kv(K + ro, V + ro, lds + k2 * 65536, lds + k2 * 65536 + 32768, tid); }
        __syncthreads();
        const float slope2 = LOG2E * __builtin_amdgcn_exp2f(-0.5f * (float)(h + 1));
#pragma unroll 1
        for (int k2 = 0; k2 < 2; ++k2) {
            const int j = 2 * jj + k2, wt = k2 == 0 ? wave : 7 - wave, tq = j * 256 + wt * 32 + r;
            bf16_t* qrow = Q + (size_t)(b * SEQ + tq) * D + h * 64;
            bf16x8 qf[4]; load_qf(qf, qrow, hh);
            float m, l; f32x16 o0, o1;
            attn_tile<true>(qf, tq, j * 256, slope2, wt + 1, lds + k2 * 65536, lds + k2 * 65536 + 32768, lane, m, l, o0, o1);
            const int nsel = j < 3 ? j : 3;
            const size_t sidx = ((size_t)(b * SEQ + tq) * H + h) * 3;
            float mr[3], lr[3], M = m;
#pragma unroll
            for (int k = 0; k < 3; ++k) { mr[k] = NEG_BIG; lr[k] = 0.f; if (k < nsel) { const f32x2 ml = *(const f32x2*)(PML + (sidx + k) * 2); mr[k] = ml.x; lr[k] = ml.y; M = fmaxf(M, ml.x); } }
            const float wo = __builtin_amdgcn_exp2f(m - M); float L = l * wo;
#pragma unroll
            for (int i = 0; i < 16; ++i) { o0[i] *= wo; o1[i] *= wo; }
#pragma unroll
            for (int k = 0; k < 3; ++k) if (k < nsel) {
                const float wk = lr[k] * __builtin_amdgcn_exp2f(mr[k] - M); L += wk;
                const bf16_t* po = PO + (sidx + k) * 64;
#pragma unroll
                for (int gq = 0; gq < 4; ++gq) { const u32x2 w0 = *(const u32x2*)(po + 8 * gq + 4 * hh), w1 = *(const u32x2*)(po + 32 + 8 * gq + 4 * hh);
                    o0[4 * gq] += wk * __builtin_bit_cast(float, w0.x << 16); o0[4 * gq + 1] += wk * __builtin_bit_cast(float, w0.x & 0xffff0000u);
                    o0[4 * gq + 2] += wk * __builtin_bit_cast(float, w0.y << 16); o0[4 * gq + 3] += wk * __builtin_bit_cast(float, w0.y & 0xffff0000u);
                    o1[4 * gq] += wk * __builtin_bit_cast(float, w1.x << 16); o1[4 * gq + 1] += wk * __builtin_bit_cast(float, w1.x & 0xffff0000u);
                    o1[4 * gq + 2] += wk * __builtin_bit_cast(float, w1.y << 16); o1[4 * gq + 3] += wk * __builtin_bit_cast(float, w1.y & 0xffff0000u); }
            }
            const float il = 1.f / L;
#pragma unroll
            for (int gq = 0; gq < 4; ++gq) { u32x2 w0, w1; w0.x = cvtpk(o0[4 * gq] * il, o0[4 * gq + 1] * il); w0.y = cvtpk(o0[4 * gq + 2] * il, o0[4 * gq + 3] * il);
                w1.x = cvtpk(o1[4 * gq] * il, o1[4 * gq + 1] * il); w1.y = cvtpk(o1[4 * gq + 2] * il, o1[4 * gq + 3] * il);
                *(u32x2*)(qrow + 8 * gq + 4 * hh) = w0; *(u32x2*)(qrow + 32 + 8 * gq + 4 * hh) = w1; }
        }
    }
}
}
#define FK_HAVE_RET 1
namespace fk {
#define MFMA16(a, b, c) __builtin_amdgcn_mfma_f32_16x16x32_bf16((a), (b), (c), 0, 0, 0)
constexpr int NBR = NB * 4;
__device__ __forceinline__ float ret_lg2(int hr) { return __builtin_log2f(1.0f - __builtin_amdgcn_exp2f(-5.0f - (float)hr)); }
__device__ __forceinline__ void ret_scores_phase(unsigned char* ws, LAS unsigned char*, int vcu, int G, int tid) {
    const bf16_t* Qr = (const bf16_t*)(ws + WS_B); const bf16_t* Kr = (const bf16_t*)(ws + WS_C); bf16_t* P = (bf16_t*)(ws + WS_A);
    const int lane = tid & 63, wave = __builtin_amdgcn_readfirstlane(tid >> 6), r = lane & 31, h = lane >> 5;
    const int qt = wave >> 1, ktp = wave & 1;
    for (int u = vcu; u < NBR * 64; u += G) {
        const int bhr = u >> 6, i = u & 63, b = bhr >> 2, hr = bhr & 3;
        const float lg2 = ret_lg2(hr);
        const bf16_t* qrow = Qr + (size_t)(b * SEQ + 128 * i + 32 * qt + r) * D + 256 * hr + 8 * h;
        bf16_t* prow = P + (size_t)u * 16384 + (size_t)(32 * qt + r) * 128;
        bf16x8 qf[16];
#pragma unroll
        for (int ks = 0; ks < 16; ++ks) qf[ks] = *(const bf16x8*)(qrow + 16 * ks);
#pragma unroll
        for (int k2 = 0; k2 < 2; ++k2) {
            const int kt = 2 * ktp + k2;
            f32x16 acc;
#pragma unroll
            for (int e = 0; e < 16; ++e) acc[e] = 0.f;
            if (kt <= qt) {
                const bf16_t* krow = Kr + (size_t)(b * SEQ + 128 * i + 32 * kt + r) * D + 256 * hr + 8 * h;
#pragma unroll
                for (int ks = 0; ks < 16; ++ks) { const bf16x8 kf = *(const bf16x8*)(krow + 16 * ks); acc = MFMA32(kf, qf[ks], acc); }
            }
            const int q = 32 * qt + r;
#pragma unroll
            for (int g4 = 0; g4 < 4; ++g4) {
                float v[4];
#pragma unroll
                for (int e = 0; e < 4; ++e) { const int key = 32 * kt + 8 * g4 + 4 * h + e; v[e] = (q >= key) ? acc[4 * g4 + e] * __builtin_amdgcn_exp2f(lg2 * (float)(q - key)) : 0.f; }
                u32x2 w; w.x = cvtpk(v[0], v[1]); w.y = cvtpk(v[2], v[3]);
                *(u32x2*)(prow + 32 * kt + 8 * g4 + 4 * h) = w;
            }
        }
    }
}
__device__ __forceinline__ void ret_scan_phase(unsigned char* ws, LAS unsigned char* lds, int vcu, int G, int tid) {
    const bf16_t* Qr = (const bf16_t*)(ws + WS_B); const bf16_t* Kr = (const bf16_t*)(ws + WS_C); bf16_t* Vr = (bf16_t*)(ws + WS_D); const bf16_t* P = (const bf16_t*)(ws + WS_A);
    constexpr int KP = 576, VP = 272, SP = 528;
    LAS unsigned char* KL = lds; LAS unsigned char* VT = lds + 128 * KP; LAS unsigned char* ST = VT + 32 * VP;
    const int lane = tid & 63, wave = __builtin_amdgcn_readfirstlane(tid >> 6), r = lane & 31, h = lane >> 5, c16 = lane & 15, kg = lane >> 4, g1 = (lane >> 4) & 1;
    for (int u = vcu; u < NBR * 16; u += G) {
        const int bhr = u >> 4, sl = u & 15, b = bhr >> 2, hr = bhr & 3;
        const float lg2 = ret_lg2(hr), cd = __builtin_amdgcn_exp2f(128.f * lg2);
        const bf16_t* Qg = Qr + (size_t)(b * SEQ) * D + 256 * hr; const bf16_t* Kg = Kr + (size_t)(b * SEQ) * D + 256 * hr;
        bf16_t* Vg = Vr + (size_t)(b * SEQ) * RV + 512 * hr + 32 * sl; const bf16_t* Pg = P + (size_t)(bhr * 64) * 16384;
        f32x16 S;
#pragma unroll
        for (int e = 0; e < 16; ++e) S[e] = 0.f;
        __syncthreads();
#pragma unroll
        for (int g4 = 0; g4 < 4; ++g4) { u32x2 z; z.x = 0u; z.y = 0u; *(LAS u32x2*)(ST + r * SP + (32 * wave + 8 * g4 + 4 * h) * 2) = z; }
        u32x4 kpre[8], vpre;
#define RET_LOADKV(ci) do { _Pragma("unroll") for (int e_ = 0; e_ < 8; ++e_) { const int idx_ = tid + 512 * e_; kpre[e_] = *(const u32x4*)(Kg + (size_t)(128 * (ci) + (idx_ >> 5)) * D + (idx_ & 31) * 8); } \
        vpre = *(const u32x4*)(Vg + (size_t)(128 * (ci) + (tid >> 2)) * RV + (tid & 3) * 8); } while (0)
        RET_LOADKV(0);
        for (int i = 0; i < 64; ++i) {
#pragma unroll
            for (int e = 0; e < 8; ++e) { const int idx = tid + 512 * e, row = idx >> 5, ch = idx & 31; const float kd = __builtin_amdgcn_exp2f(lg2 * (float)(127 - row));
                u32x4 w = kpre[e];
                w.x = cvtpk(__builtin_bit_cast(float, w.x << 16) * kd, __builtin_bit_cast(float, w.x & 0xffff0000u) * kd); w.y = cvtpk(__builtin_bit_cast(float, w.y << 16) * kd, __builtin_bit_cast(float, w.y & 0xffff0000u) * kd);
                w.z = cvtpk(__builtin_bit_cast(float, w.z << 16) * kd, __builtin_bit_cast(float, w.z & 0xffff0000u) * kd); w.w = cvtpk(__builtin_bit_cast(float, w.w << 16) * kd, __builtin_bit_cast(float, w.w & 0xffff0000u) * kd);
                *(LAS u32x4*)(KL + row * KP + ch * 16) = w; }
            { const int pos = tid >> 2, dv0 = (tid & 3) * 8; LAS unsigned short* vt = (LAS unsigned short*)(VT + dv0 * VP + pos * 2);
              vt[0 * (VP / 2)] = (unsigned short)(vpre.x & 0xffffu); vt[1 * (VP / 2)] = (unsigned short)(vpre.x >> 16); vt[2 * (VP / 2)] = (unsigned short)(vpre.y & 0xffffu); vt[3 * (VP / 2)] = (unsigned short)(vpre.y >> 16);
              vt[4 * (VP / 2)] = (unsigned short)(vpre.z & 0xffffu); vt[5 * (VP / 2)] = (unsigned short)(vpre.z >> 16); vt[6 * (VP / 2)] = (unsigned short)(vpre.w & 0xffffu); vt[7 * (VP / 2)] = (unsigned short)(vpre.w >> 16); }
            __syncthreads();
            if (i + 1 < 64) RET_LOADKV(i + 1);
            f32x4 ain[2], acr[2];
#pragma unroll
            for (int ct = 0; ct < 2; ++ct) { ain[ct] = (f32x4){0.f, 0.f, 0.f, 0.f}; acr[ct] = (f32x4){0.f, 0.f, 0.f, 0.f}; }
            { const bf16_t* pa = Pg + (size_t)i * 16384 + (16 * wave + c16) * 128 + 8 * kg;
#pragma unroll
              for (int ks = 0; ks < 4; ++ks) { const bf16x8 a = *(const bf16x8*)(pa + 32 * ks);
#pragma unroll
                  for (int ct = 0; ct < 2; ++ct) { const bf16x8 bb = *(LAS const bf16x8*)(VT + (16 * ct + c16) * VP + (32 * ks + 8 * kg) * 2); ain[ct] = MFMA16(a, bb, ain[ct]); } }
              const bf16_t* qa = Qg + (size_t)(128 * i + 16 * wave + c16) * D + 8 * kg;
#pragma unroll
              for (int ks = 0; ks < 8; ++ks) { const bf16x8 a = *(const bf16x8*)(qa + 32 * ks);
#pragma unroll
                  for (int ct = 0; ct < 2; ++ct) { const bf16x8 bb = *(LAS const bf16x8*)(ST + (16 * ct + c16) * SP + (32 * ks + 8 * kg) * 2); acr[ct] = MFMA16(a, bb, acr[ct]); } } }
#pragma unroll
            for (int e = 0; e < 4; ++e) { const int q = 16 * wave + 4 * kg + e; const float qd = __builtin_amdgcn_exp2f(lg2 * (float)(q + 1));
                bf16_t* orow = Vg + (size_t)(128 * i + q) * RV + c16;
#pragma unroll
                for (int ct = 0; ct < 2; ++ct) orow[16 * ct] = (bf16_t)f2bf(ain[ct][e] + qd * acr[ct][e]); }
#pragma unroll
            for (int e = 0; e < 16; ++e) S[e] *= cd;
            { LAS const unsigned char* kb = KL + (8 * h + (c16 >> 2)) * KP + (32 * wave + 16 * g1 + 4 * (c16 & 3)) * 2;
#pragma unroll
              for (int s = 0; s < 8; ++s) { const s16x4 lo = tr_read(kb + (16 * s) * KP), hi = tr_read(kb + (16 * s + 4) * KP); const bf16x8 af = __builtin_shufflevector(lo, hi, 0, 1, 2, 3, 4, 5, 6, 7);
                  const bf16x8 bb = *(LAS const bf16x8*)(VT + r * VP + (16 * s + 8 * h) * 2); S = MFMA32(af, bb, S); } }
            __syncthreads();
#pragma unroll
            for (int g4 = 0; g4 < 4; ++g4) { u32x2 w; w.x = cvtpk(S[4 * g4], S[4 * g4 + 1]); w.y = cvtpk(S[4 * g4 + 2], S[4 * g4 + 3]); *(LAS u32x2*)(ST + r * SP + (32 * wave + 8 * g4 + 4 * h) * 2) = w; }
        }
#undef RET_LOADKV
    }
}
__device__ __forceinline__ void ret_gn_phase(unsigned char* ws, const float* gn_g, const float* gn_b, int gw, int ngw, int lane) {
    bf16_t* O = (bf16_t*)(ws + WS_D); const bf16_t* GS = (const bf16_t*)(ws + WS_F);
    for (int u = gw; u < T * 4; u += ngw) {
        const int t = u >> 2, hr = u & 3; const size_t off = (size_t)t * RV + 512 * hr + 8 * lane;
        const u32x4 w = *(const u32x4*)(O + off), gs = *(const u32x4*)(GS + off);
        float v[8] = {__builtin_bit_cast(float, w.x << 16), __builtin_bit_cast(float, w.x & 0xffff0000u), __builtin_bit_cast(float, w.y << 16), __builtin_bit_cast(float, w.y & 0xffff0000u),
                      __builtin_bit_cast(float, w.z << 16), __builtin_bit_cast(float, w.z & 0xffff0000u), __builtin_bit_cast(float, w.w << 16), __builtin_bit_cast(float, w.w & 0xffff0000u)};
        const float gv[8] = {__builtin_bit_cast(float, gs.x << 16), __builtin_bit_cast(float, gs.x & 0xffff0000u), __builtin_bit_cast(float, gs.y << 16), __builtin_bit_cast(float, gs.y & 0xffff0000u),
                             __builtin_bit_cast(float, gs.z << 16), __builtin_bit_cast(float, gs.z & 0xffff0000u), __builtin_bit_cast(float, gs.w << 16), __builtin_bit_cast(float, gs.w & 0xffff0000u)};
        float s = 0.f;
#pragma unroll
        for (int e = 0; e < 8; ++e) s += v[e];
        const float mu = wave_sum(s) * (1.f / 512.f); float q = 0.f;
#pragma unroll
        for (int e = 0; e < 8; ++e) { v[e] -= mu; q += v[e] * v[e]; }
        const float rstd = 1.f / sqrtf(wave_sum(q) * (1.f / 512.f) + GN_EPS);
        const f32x4 ga = *(const f32x4*)(gn_g + 512 * hr + 8 * lane), gb2 = *(const f32x4*)(gn_g + 512 * hr + 8 * lane + 4), ba = *(const f32x4*)(gn_b + 512 * hr + 8 * lane), bb2 = *(const f32x4*)(gn_b + 512 * hr + 8 * lane + 4);
        float o[8];
#pragma unroll
        for (int e = 0; e < 4; ++e) { o[e] = (v[e] * rstd * ga[e] + ba[e]) * gv[e]; o[4 + e] = (v[4 + e] * rstd * gb2[e] + bb2[e]) * gv[4 + e]; }
        u32x4 ow; ow.x = pk2(o[0], o[1]); ow.y = pk2(o[2], o[3]); ow.z = pk2(o[4], o[5]); ow.w = pk2(o[6], o[7]);
        *(u32x4*)(O + off) = ow;
    }
}
}
namespace fk {
struct FArgs { const float* in[15]; float* out; unsigned char* ws; int ph_lo, ph_hi, li, pad; };
constexpr int NWAVES = 8, LDS_BYTES = 147456, RING_BYTES = 131072, MISC_OFF = RING_BYTES + 320;
constexpr int NPHASE = 22;

__global__ void __launch_bounds__(512, 2) fwd(FArgs a) {
    extern __shared__ __attribute__((aligned(16))) unsigned char lds_raw[];
    LAS unsigned char* lds = (LAS unsigned char*)lds_raw;
    const int tid = threadIdx.x, lane = tid & 63, wave = __builtin_amdgcn_readfirstlane(tid >> 6);
    const int G = gridDim.x, bx = blockIdx.x, vcu = (G % 8 == 0) ? (bx % 8) * (G / 8) + bx / 8 : bx;
    volatile LAS unsigned* MISC = (volatile LAS unsigned*)(lds + MISC_OFF);
    for (int u = tid; u < (LDS_BYTES - RING_BYTES) / 4; u += NWAVES * 64) ((LAS unsigned*)(lds + RING_BYTES))[u] = 0u;
    __syncthreads();
    unsigned char* ws = a.ws;
    unsigned* ctl = (unsigned*)(ws + WS_CTL);
    XcdBarrier bar = xcd_barrier_post(ctl + CW_BAR + a.li * XCD_BAR_WORDS, MISC + 8);
    const int gw = vcu * NWAVES + wave, ngw = G * NWAVES, gtid = gw * 64 + lane, ngt = ngw * 64;
    const int lo = a.ph_lo, hi = a.ph_hi;
    const float* x = a.in[0];
    const float* att_w_in = a.in[1]; const float* att_w_out = a.in[2]; const float* ret_w_in = a.in[3]; const float* ret_w_out = a.in[4];
    const float* ret_gn_g = a.in[5]; const float* ret_gn_b = a.in[6]; const float* mix_ln_g = a.in[7]; const float* mix_ln_b = a.in[8];
    const float* ffn_ln_g = a.in[9]; const float* ffn_ln_b = a.in[10]; const float* ffn_w_up = a.in[11]; const float* ffn_conv_w = a.in[12];
    const float* ffn_conv_b = a.in[13]; const float* ffn_w_down = a.in[14];
    bf16_t* Wqkv = (bf16_t*)(ws + WS_WQKV); bf16_t* Wao = (bf16_t*)(ws + WS_WAO); bf16_t* Wri = (bf16_t*)(ws + WS_WRI); bf16_t* Wro = (bf16_t*)(ws + WS_WRO);
    bf16_t* Wup0 = (bf16_t*)(ws + WS_WUP0); bf16_t* Wup1 = (bf16_t*)(ws + WS_WUP1); bf16_t* Wdn0 = (bf16_t*)(ws + WS_WDN0); bf16_t* Wdn1 = (bf16_t*)(ws + WS_WDN1);
#define IN(k) (lo <= (k) && (k) < hi)
#define SEAM(k) do { if (IN(k) && IN((k) + 1)) xcd_barrier(bar); } while (0)
#define GEMM_PHASE(EPI_T, e, Aptr, Bptr, Nv, Kv) do { pg8::Gemm g_{(const bf16_t*)(Aptr), (const bf16_t*)(Bptr), T, (Nv), (Kv)}; pg8::StaticOrder S_; S_.init(T, (Nv), G, bx); \
        pg8::gemm_phase<EPI_T, pg8::StaticOrder, true, true>(lds, g_, S_, e); } while (0)

    if (IN(0)) {
        LAS float* scr = (LAS float*)(lds + wave * 16384);
        constexpr int I_QKV = (D / 64) * (3 * D / 32), I_AO = (D / 64) * (D / 32), I_RI = (D / 64) * (RIN / 32), I_RO = (RV / 64) * (D / 32), I_UP = (D / 64) * (F2 / 32), I_DN = (F / 64) * (D / 32);
        constexpr int NITEMS = I_QKV + I_AO + I_RI + I_RO + 2 * I_UP + 2 * I_DN;
        for (int it = gw; it < NITEMS; it += ngw) {
            int r = it;
            if (r < I_QKV) { transpose_item<0>(att_w_in, D, 3 * D, Wqkv, scr, r, lane); continue; } r -= I_QKV;
            if (r < I_AO) { transpose_item<0>(att_w_out, D, D, Wao, scr, r, lane); continue; } r -= I_AO;
            if (r < I_RI) { transpose_item<0>(ret_w_in, D, RIN, Wri, scr, r, lane); continue; } r -= I_RI;
            if (r < I_RO) { transpose_item<0>(ret_w_out, RV, D, Wro, scr, r, lane); continue; } r -= I_RO;
            if (r < I_UP) { transpose_item<1>(ffn_w_up, D, F2, Wup0, scr, r, lane); continue; } r -= I_UP;
            if (r < I_UP) { transpose_item<1>(ffn_w_up + (size_t)D * F2, D, F2, Wup1, scr, r, lane); continue; } r -= I_UP;
            if (r < I_DN) { transpose_item<0>(ffn_w_down, F, D, Wdn0, scr, r, lane); continue; } r -= I_DN;
            transpose_item<0>(ffn_w_down + (size_t)F * D, F, D, Wdn1, scr, r, lane);
        }
        bf16_t* XN0 = (bf16_t*)(ws + WS_G);
        for (size_t i = gtid; i < (size_t)T * D / 4; i += ngt) { const f32x4 v = ((const f32x4*)x)[i]; u32x2 w; w.x = pk2(v[0], v[1]); w.y = pk2(v[2], v[3]); ((u32x2*)XN0)[i] = w; }
    }
    SEAM(0);
    if (IN(1)) { pg8::EpiBf16<0> E{(bf16_t*)(ws + WS_A), D, nullptr, D, SLOT / 2, C2}; GEMM_PHASE(pg8::EpiBf16<0>, E, ws + WS_G, Wqkv, 3 * D, D); }
    SEAM(1);
#ifdef FK_HAVE_ATTN
    if (IN(2)) attn_kmean_phase(ws, lds, gw, ngw, lane);
    SEAM(2);
    if (IN(3)) attn_gate_phase(ws, lds, vcu, G, tid);
    SEAM(3);
    if (IN(4)) attn_sel_phase(ws, lds, vcu, G, tid);
    SEAM(4);
    if (IN(5)) attn_own_phase(ws, lds, vcu, G, tid);
    SEAM(5);
#endif
    if (IN(6)) { EpiResid E{x, (float*)(ws + WS_D)}; GEMM_PHASE(EpiResid, E, ws + WS_A, Wao, D, D); }
    SEAM(6);
    if (IN(7)) ln_phase((const float*)(ws + WS_D), mix_ln_g, mix_ln_b, (float*)(ws + WS_B), (bf16_t*)(ws + WS_A), gw, ngw, lane);
    SEAM(7);
    if (IN(8)) { EpiUp E{(bf16_t*)(ws + WS_D), ffn_conv_w, ffn_conv_b, (float*)(ws + WS_UBUF0)}; GEMM_PHASE(EpiUp, E, ws + WS_A, Wup0, F2, D); }
    SEAM(8);
    if (IN(9)) fixup_phase((const float*)(ws + WS_UBUF0), ffn_conv_w, ffn_conv_b, (bf16_t*)(ws + WS_D), gtid, ngt);
    SEAM(9);
    if (IN(10)) { EpiResid E{(const float*)(ws + WS_B), (float*)(ws + WS_B)}; GEMM_PHASE(EpiResid, E, ws + WS_D, Wdn0, D, F); }
    SEAM(10);
    if (IN(11)) ln_phase((const float*)(ws + WS_B), ffn_ln_g, ffn_ln_b, a.out, (bf16_t*)(ws + WS_A), gw, ngw, lane);
    SEAM(11);
    if (IN(12)) { EpiRetIn E{(bf16_t*)(ws + WS_B), (bf16_t*)(ws + WS_C), (bf16_t*)(ws + WS_D), (bf16_t*)(ws + WS_F)}; GEMM_PHASE(EpiRetIn, E, ws + WS_A, Wri, RIN, D); }
    SEAM(12);
#ifdef FK_HAVE_RET
    if (IN(13)) ret_scores_phase(ws, lds, vcu, G, tid);
    SEAM(13);
    if (IN(14)) ret_scan_phase(ws, lds, vcu, G, tid);
    SEAM(14);
    if (IN(15)) ret_gn_phase(ws, ret_gn_g, ret_gn_b, gw, ngw, lane);
    SEAM(15);
#endif
    if (IN(16)) { EpiResid E{a.out, a.out}; GEMM_PHASE(EpiResid, E, ws + WS_D, Wro, D, RV); }
    SEAM(16);
    if (IN(17)) ln_phase(a.out, mix_ln_g + D, mix_ln_b + D, (float*)(ws + WS_B), (bf16_t*)(ws + WS_G), gw, ngw, lane);
    SEAM(17);
    if (IN(18)) { EpiUp E{(bf16_t*)(ws + WS_D), ffn_conv_w + 3 * F2, ffn_conv_b + F2, (float*)(ws + WS_UBUF1)}; GEMM_PHASE(EpiUp, E, ws + WS_G, Wup1, F2, D); }
    SEAM(18);
    if (IN(19)) fixup_phase((const float*)(ws + WS_UBUF1), ffn_conv_w + 3 * F2, ffn_conv_b + F2, (bf16_t*)(ws + WS_D), gtid, ngt);
    SEAM(19);
    if (IN(20)) { EpiResid E{(const float*)(ws + WS_B), (float*)(ws + WS_B)}; GEMM_PHASE(EpiResid, E, ws + WS_D, Wdn1, D, F); }
    SEAM(20);
    if (IN(21)) ln_phase((const float*)(ws + WS_B), ffn_ln_g + D, ffn_ln_b + D, a.out, nullptr, gw, ngw, lane);
#undef IN
#undef SEAM
#undef GEMM_PHASE
}

static int g_grid = 0;
static void fk_init() {
    if (g_grid) return;
    int dev = 0, cus = 0, per_cu = 0;
    hipGetDevice(&dev); hipDeviceGetAttribute(&cus, hipDeviceAttributeMultiprocessorCount, dev);
    hipFuncSetAttribute((const void*)fwd, hipFuncAttributeMaxDynamicSharedMemorySize, LDS_BYTES);
    hipOccupancyMaxActiveBlocksPerMultiprocessor(&per_cu, (const void*)fwd, NWAVES * 64, LDS_BYTES);
    (void)hipGetLastError();
    if (per_cu < 1) per_cu = 1;
    g_grid = cus * per_cu;
}
static void fk_launch(void* const* d_in, float* out, unsigned char* ws, int lo, int hi, int li, hipStream_t s, const float* in0_override = nullptr) {
    fk_init();
    FArgs a{};
    for (int i = 0; i < 15; ++i) a.in[i] = (const float*)d_in[i];
    if (in0_override) a.in[0] = in0_override;
    a.out = out; a.ws = ws; a.ph_lo = lo; a.ph_hi = hi; a.li = li; a.pad = 0;
    hipLaunchKernelGGL(fwd, dim3(g_grid), dim3(NWAVES * 64), LDS_BYTES, s, a);
}
}
extern "C" void kernel_launch(void* const* d_in, const int* in_sizes, int n_in, void* d_out, int out_size, void* d_ws, size_t ws_size, hipStream_t stream) {
    (void)in_sizes; (void)n_in; (void)out_size; (void)ws_size;
    hipMemsetAsync((unsigned char*)d_ws + fk::WS_CTL, 0, fk::CTL_ZERO_BYTES, stream);
    for (int p = 0; p < fk::NPHASE; ++p) fk::fk_launch(d_in, (float*)d_out, (unsigned char*)d_ws, p, p + 1, 0, stream);
}
```
